# Optimizing an MI355X kernel written in HIP

```python
import jax, jax.numpy as jnp
from jax import lax
import numpy as np

D_MODEL = 1024
BATCH = 2
SEQ = 8192
DEPTH = 2
DEC_BATCH = 4
DEC_SEQ = 4096
PAST_LEN = 128

MIX_WIDTH = D_MODEL
HEAD_DIM = 64
D_FOURIER = MIX_WIDTH // 2
D_LRU = MIX_WIDTH - D_FOURIER
N_FOURIER_HEADS = D_FOURIER // HEAD_DIM
N_LRU_HEADS = D_LRU // HEAD_DIM
D_IN = D_FOURIER + 2 * D_LRU
CONV_WIDTH = 4
CONV_PAD_LEFT = 2
CONV_PAD_RIGHT = CONV_WIDTH - 1 - CONV_PAD_LEFT
LRU_C = 8.0
D_FF = 4 * D_MODEL
N_MOD = 6
EPS = 1e-6

kernel_name = "hybrid_fnet_rglru_adaln_encoder"


def rms_norm(x, g):
    xf = x.astype(jnp.float32)
    y = xf * lax.rsqrt(jnp.mean(xf * xf, axis=-1, keepdims=True) + EPS)
    return (y * g.astype(jnp.float32)).astype(x.dtype)


def fourier_mixer(u, w_f):
    b, s, _ = u.shape
    uh = u.reshape(b, s, N_FOURIER_HEADS, HEAD_DIM).astype(jnp.float32)
    f = jnp.fft.fft2(uh, axes=(1, 3), norm="ortho").real.astype(u.dtype)
    y = jnp.einsum("bshd,hde->bshe", f, w_f)
    return y.reshape(b, s, D_FOURIER)


def centred_depthwise_conv(u, w, bias):
    s = u.shape[1]
    up = jnp.pad(u, ((0, 0), (CONV_PAD_LEFT, CONV_PAD_RIGHT), (0, 0)))
    out = bias
    for k in range(CONV_WIDTH):
        out = out + up[:, k:k + s, :] * w[k]
    return out


def _lru_combine(e1, e2):
    a1, b1 = e1
    a2, b2 = e2
    return a1 * a2, a2 * b1 + b2


def rglru_direction(x, w_r, b_r, w_i, b_i, lam, reverse):
    b, s, _ = x.shape
    xh = x.reshape(b, s, N_LRU_HEADS, HEAD_DIM)
    r = jax.nn.sigmoid(jnp.einsum("bshd,hde->bshe", xh, w_r) + b_r).reshape(b, s, D_LRU)
    i = jax.nn.sigmoid(jnp.einsum("bshd,hde->bshe", xh, w_i) + b_i).reshape(b, s, D_LRU)
    log_a = -LRU_C * r * jax.nn.softplus(-lam)
    a = jnp.exp(log_a)
    mult = jnp.sqrt(jnp.maximum(-jnp.expm1(2.0 * log_a), 0.0))
    bx = mult * (i * x)
    _, h = lax.associative_scan(_lru_combine, (a, bx), axis=1, reverse=reverse)
    return h


def bidirectional_rglru(u, w_rg, b_rg, w_ig, b_ig, lam):
    uf = u.astype(jnp.float32)
    w_rg = w_rg.astype(jnp.float32); b_rg = b_rg.astype(jnp.float32)
    w_ig = w_ig.astype(jnp.float32); b_ig = b_ig.astype(jnp.float32)
    lam = lam.astype(jnp.float32)
    h_fwd = rglru_direction(uf, w_rg[0], b_rg[0], w_ig[0], b_ig[0], lam[0], reverse=False)
    h_bwd = rglru_direction(uf, w_rg[1], b_rg[1], w_ig[1], b_ig[1], lam[1], reverse=True)
    return (h_fwd + h_bwd).astype(u.dtype)


def encoder_layer(x, c, g_mix, g_mlp, w_mod, b_mod, w_in, w_fourier, conv_w, conv_b,
                  w_rgate, b_rgate, w_igate, b_igate, lru_lambda, w_out, w_ff1, w_ff2):
    mod = jax.nn.silu(c.astype(jnp.float32)) @ w_mod.astype(jnp.float32) + b_mod.astype(jnp.float32)
    mod = mod.astype(x.dtype)[:, None, :]
    shift1, scale1, gate1, shift2, scale2, gate2 = jnp.split(mod, N_MOD, axis=-1)

    h = rms_norm(x, g_mix) * (1.0 + scale1) + shift1
    z = h @ w_in
    u_f = z[..., :D_FOURIER]
    u_r = z[..., D_FOURIER:D_FOURIER + D_LRU]
    u_g = z[..., D_FOURIER + D_LRU:]
    y_f = fourier_mixer(u_f, w_fourier)
    u_c = centred_depthwise_conv(u_r, conv_w, conv_b)
    y_r = bidirectional_rglru(u_c, w_rgate, b_rgate, w_igate, b_igate, lru_lambda) * jax.nn.gelu(u_g)
    mix = jnp.concatenate([y_f, y_r], axis=-1) @ w_out
    x = x + gate1 * mix

    h = rms_norm(x, g_mlp) * (1.0 + scale2) + shift2
    ff = jnp.square(jax.nn.relu(h @ w_ff1)) @ w_ff2
    return x + gate2 * ff


def trunk(x, c, g_mix, g_mlp, w_mod, b_mod, w_in, w_fourier, conv_w, conv_b,
          w_rgate, b_rgate, w_igate, b_igate, lru_lambda, w_out, w_ff1, w_ff2, g_final):
    for l in range(DEPTH):
        x = encoder_layer(x, c, g_mix[l], g_mlp[l], w_mod[l], b_mod[l], w_in[l], w_fourier[l],
                          conv_w[l], conv_b[l], w_rgate[l], b_rgate[l], w_igate[l], b_igate[l],
                          lru_lambda[l], w_out[l], w_ff1[l], w_ff2[l])
    return rms_norm(x, g_final)


def setup_inputs(seed: int = 0) -> dict:
    key = jax.random.key(seed)
    ks = jax.random.split(key, 24)
    f32 = jnp.float32
    nrm = lambda k, shape, scale: (jax.random.normal(k, shape, f32) * scale).astype(f32)
    a0 = jax.random.uniform(ks[18], (DEPTH, 2, D_LRU), f32, 0.9, 0.999)
    return {
        "x_prompt": nrm(ks[0], (BATCH, SEQ, D_MODEL), 1.0),
        "x_sample": nrm(ks[1], (DEC_BATCH, DEC_SEQ, D_MODEL), 1.0),
        "c_prompt": nrm(ks[2], (BATCH, D_MODEL), 1.0),
        "c_sample": nrm(ks[3], (DEC_BATCH, D_MODEL), 1.0),
        "g_mix": 1.0 + nrm(ks[4], (DEPTH, D_MODEL), 0.02),
        "g_mlp": 1.0 + nrm(ks[5], (DEPTH, D_MODEL), 0.02),
        "w_mod": nrm(ks[6], (DEPTH, D_MODEL, N_MOD * D_MODEL), 0.5 * D_MODEL ** -0.5),
        "b_mod": nrm(ks[7], (DEPTH, N_MOD * D_MODEL), 0.02),
        "w_in": nrm(ks[8], (DEPTH, D_MODEL, D_IN), D_MODEL ** -0.5),
        "w_fourier": nrm(ks[9], (DEPTH, N_FOURIER_HEADS, HEAD_DIM, HEAD_DIM), HEAD_DIM ** -0.5),
        "conv_w": nrm(ks[10], (DEPTH, CONV_WIDTH, D_LRU), 0.5),
        "conv_b": nrm(ks[11], (DEPTH, D_LRU), 0.02),
        "w_rgate": nrm(ks[12], (DEPTH, 2, N_LRU_HEADS, HEAD_DIM, HEAD_DIM), HEAD_DIM ** -0.5),
        "b_rgate": nrm(ks[13], (DEPTH, 2, N_LRU_HEADS, HEAD_DIM), 0.02),
        "w_igate": nrm(ks[14], (DEPTH, 2, N_LRU_HEADS, HEAD_DIM, HEAD_DIM), HEAD_DIM ** -0.5),
        "b_igate": nrm(ks[15], (DEPTH, 2, N_LRU_HEADS, HEAD_DIM), 0.02),
        "lru_lambda": jnp.log(a0) - jnp.log1p(-a0),
        "w_out": nrm(ks[16], (DEPTH, MIX_WIDTH, D_MODEL), MIX_WIDTH ** -0.5),
        "w_ff1": nrm(ks[17], (DEPTH, D_MODEL, D_FF), D_MODEL ** -0.5),
        "w_ff2": nrm(ks[19], (DEPTH, D_FF, D_MODEL), D_FF ** -0.5),
        "g_final": 1.0 + nrm(ks[20], (D_MODEL,), 0.02),
    }


def reference(x_prompt, x_sample, c_prompt, c_sample, g_mix, g_mlp, w_mod, b_mod, w_in,
              w_fourier, conv_w, conv_b, w_rgate, b_rgate, w_igate, b_igate, lru_lambda,
              w_out, w_ff1, w_ff2, g_final):
    y_prompt = trunk(x_prompt, c_prompt, g_mix, g_mlp, w_mod, b_mod, w_in, w_fourier, conv_w,
                     conv_b, w_rgate, b_rgate, w_igate, b_igate, lru_lambda, w_out, w_ff1,
                     w_ff2, g_final)
    y_sample = trunk(x_sample, c_sample, g_mix, g_mlp, w_mod, b_mod, w_in, w_fourier, conv_w,
                     conv_b, w_rgate, b_rgate, w_igate, b_igate, lru_lambda, w_out, w_ff1,
                     w_ff2, g_final)
    return (y_prompt, y_sample)
```

```cpp
#include <hip/hip_runtime.h>
#include <cstdio>
#include <cstdint>
#include <cstddef>
namespace pg8 {
#define PG8_LAS __attribute__((address_space(3)))
typedef unsigned short bf16_t;
typedef short bf16x8 __attribute__((ext_vector_type(8)));
typedef float f32x4 __attribute__((ext_vector_type(4)));
typedef unsigned u32x4 __attribute__((ext_vector_type(4)));
constexpr int BM = 256, BK = 64, HALF = 128, HTB = HALF * BK * 2  , STAGE_BYTES = 8 * HTB, NXCD = 8, WGM = 8;

__host__ __device__ __forceinline__ int lds_byte(int r, int c) { const int st = (r >> 4) * 2 + (c >> 5), rr = r & 15, cc = c & 31, ob = rr * 64 + cc * 2; return st * 1024 + (ob ^ (((ob >> 9) & 1) << 5)); }
__host__ __device__ __forceinline__ void stage_rc(int b, int& R, int& C) { const int st = b / 1024, sb = b % 1024, swz = sb ^ (((sb >> 9) & 1) << 5); R = (st >> 1) * 16 + swz / 64; C = (st & 1) * 32 + (swz % 64) / 2; }
__host__ __device__ __forceinline__ int perm32(int rho) { const int n = rho >> 4, i = rho & 15; return 8 * (i >> 2) + 4 * n + (i & 3); }

struct Unit { int pm, pn; };
struct Gemm { const bf16_t* A; const bf16_t* Bt; int M, N, K; };

struct StaticOrder {
    int nM, nN, nwg, G, c;
    __host__ __device__ void init(int M, int N, int G_, int c_) { nM = M / BM; nN = N / BM; nwg = nM * nN; G = G_; c = c_; }
    __host__ __device__ bool next(int i, Unit& u) const {
        const long L = (long)i * G + c; if (L >= nwg) return false;
        int wgid = (int)L; { const int q = nwg / NXCD, r = nwg % NXCD, xcd = wgid % NXCD, off = wgid / NXCD; wgid = (xcd < r ? xcd * (q + 1) : r * (q + 1) + (xcd - r) * q) + off; }
        const int nig = WGM * nN, gid = wgid / nig, fm = gid * WGM, gsz = (nM - fm) < WGM ? (nM - fm) : WGM;
        u.pm = fm + ((wgid % nig) % gsz); u.pn = (wgid % nig) / gsz; return true;
    }
    __device__ __forceinline__ void a_ready(const Unit&) const {}
    __device__ __forceinline__ void done(const Unit&) const {}
};

__device__ __forceinline__ unsigned cvt_pk_bf16(float lo, float hi) { unsigned r; asm volatile("v_cvt_pk_bf16_f32 %0, %1, %2" : "=v"(r) : "v"(lo), "v"(hi)); return r; }
__device__ __forceinline__ int seq_of_row(int row) { return row < 16384 ? (row >> 13) : 2 + ((row - 16384) >> 12); }
constexpr int SS_SLOTS = 16;
__device__ __forceinline__ float row_rscale(const float* ss, int row) {
    const f32x4* p = (const f32x4*)(ss + (size_t)row * SS_SLOTS);
    f32x4 a = p[0], b = p[1], c = p[2], d = p[3];
    a = (a + b) + (c + d);
    const float s = (a[0] + a[1]) + (a[2] + a[3]);
    return __builtin_amdgcn_rsqf(s * (1.0f / 1024.0f) + 1e-6f);
}
template <int ACT> struct EpiScaleBias {
    static constexpr bool PERM = true, AFTER_DRAIN = false;
    bf16_t* O; int ldc; const float* ss; const float* bias;
    __device__ __forceinline__ void operator()(const f32x4 (&acc)[2][2][4][2], const Unit& u, int wr, int wc, int fr, int fq) const {
        const int row0 = u.pm * BM + wr * 64 + fr, col0 = u.pn * BM + wc * 32 + 8 * fq;
        const int b = seq_of_row(u.pm * BM);
        const float* bp = bias + (size_t)b * ldc + col0;
        f32x4 bv[2][2];
#pragma unroll
        for (int bj = 0; bj < 2; ++bj)
#pragma unroll
            for (int n = 0; n < 2; ++n) bv[bj][n] = *(const f32x4*)(bp + bj * HALF + 4 * n);
#pragma unroll
        for (int ai = 0; ai < 2; ++ai)
#pragma unroll
            for (int m = 0; m < 4; ++m) { const int row = row0 + ai * HALF + m * 16; const float r = row_rscale(ss, row);
                bf16_t* rowp = O + (size_t)row * ldc + col0;
#pragma unroll
                for (int bj = 0; bj < 2; ++bj) { f32x4 v0 = acc[ai][bj][m][0] * r + bv[bj][0], v1 = acc[ai][bj][m][1] * r + bv[bj][1];
                    if (ACT == 1) {
#pragma unroll
                        for (int j = 0; j < 4; ++j) { const float a0 = fmaxf(v0[j], 0.f), a1 = fmaxf(v1[j], 0.f); v0[j] = a0 * a0; v1[j] = a1 * a1; } }
                    u32x4 w; w.x = cvt_pk_bf16(v0[0], v0[1]); w.y = cvt_pk_bf16(v0[2], v0[3]); w.z = cvt_pk_bf16(v1[0], v1[1]); w.w = cvt_pk_bf16(v1[2], v1[3]);
                    *(u32x4*)(rowp + bj * HALF) = w; } }
    }
};
struct EpiResidual {
    static constexpr bool PERM = true, AFTER_DRAIN = false;
    const float* xin0; const float* xin1;
    float* xout; bf16_t* An; float* ss; const float* gate; const float* alpha;
    __device__ __forceinline__ void operator()(const f32x4 (&acc)[2][2][4][2], const Unit& u, int wr, int wc, int fr, int fq) const {
        const int row0 = u.pm * BM + wr * 64 + fr, col0 = u.pn * BM + wc * 32 + 8 * fq;
        const int b = seq_of_row(u.pm * BM);
        f32x4 gv[2][2], av[2][2];
#pragma unroll
        for (int bj = 0; bj < 2; ++bj)
#pragma unroll
            for (int n = 0; n < 2; ++n) { gv[bj][n] = *(const f32x4*)(gate + (size_t)b * 4096 + col0 + bj * HALF + 4 * n); av[bj][n] = *(const f32x4*)(alpha + (size_t)b * 4096 + col0 + bj * HALF + 4 * n); }
#pragma unroll
        for (int ai = 0; ai < 2; ++ai)
#pragma unroll
            for (int m = 0; m < 4; ++m) { const int row = row0 + ai * HALF + m * 16;
                const float* xr = (row < 16384 ? xin0 + (size_t)row * 1024 : xin1 + (size_t)(row - 16384) * 1024) + col0;
                float* xo = xout + (size_t)row * 1024 + col0;
                float sp = 0.f;
#pragma unroll
                for (int bj = 0; bj < 2; ++bj) {
                    const f32x4 x0 = *(const f32x4*)(xr + bj * HALF), x1 = *(const f32x4*)(xr + bj * HALF + 4);
                    const f32x4 y0 = x0 + gv[bj][0] * acc[ai][bj][m][0], y1 = x1 + gv[bj][1] * acc[ai][bj][m][1];
                    *(f32x4*)(xo + bj * HALF) = y0; *(f32x4*)(xo + bj * HALF + 4) = y1;
                    sp += (y0[0] * y0[0] + y0[1] * y0[1]) + (y0[2] * y0[2] + y0[3] * y0[3]) + (y1[0] * y1[0] + y1[1] * y1[1]) + (y1[2] * y1[2] + y1[3] * y1[3]);
                    if (An) { const f32x4 a0 = y0 * av[bj][0], a1 = y1 * av[bj][1];
                        u32x4 w; w.x = cvt_pk_bf16(a0[0], a0[1]); w.y = cvt_pk_bf16(a0[2], a0[3]); w.z = cvt_pk_bf16(a1[0], a1[1]); w.w = cvt_pk_bf16(a1[2], a1[3]);
                        *(u32x4*)(An + (size_t)row * 1024 + col0 + bj * HALF) = w; } }
                sp += __shfl_xor(sp, 16); sp += __shfl_xor(sp, 32);
                if (fq == 0) ss[(size_t)row * SS_SLOTS + u.pn * 4 + wc] = sp; }
    }
};
template <class Epi, class Sched, bool ALIGN_EPI = false, bool SP2 = false>
__device__ __forceinline__ void gemm_phase(PG8_LAS unsigned char* lds, const Gemm g, const Sched& S, const Epi& E, const int tid) {
    const int wid = __builtin_amdgcn_readfirstlane(tid >> 6), lane = tid & 63, wr = wid >> 2, wc = wid & 3, fr = lane & 15, fq = lane >> 4;
    const int K = g.K, nt = K / BK;
    unsigned voffA[2], voffB[2];
#pragma unroll
    for (int i = 0; i < 2; ++i) { int R, C; stage_rc(tid * 16 + i * 8192, R, C); const int Rb = Epi::PERM ? ((R & ~31) + perm32(R & 31)) : R;
        voffA[i] = (unsigned)(R * K + C) * 2u; voffB[i] = (unsigned)(Rb * K + C) * 2u; }
    const size_t kstep = (size_t)(BK * 2);
    const size_t hstep = (size_t)HALF * K * 2;
    const size_t tstep = 2 * hstep;
    const unsigned ldsw = (unsigned)wid * 1024u;
    const int aoff = lds_byte(wr * 64 + fr, fq * 8), boff = lds_byte(wc * 32 + fr, fq * 8);
#define PG8_SA(b, h) (((b) * 2 + (h)) * HTB)
#define PG8_SB(b, h) ((4 + (b) * 2 + (h)) * HTB)
#define PG8_STAGE(bufoff, gbase, voff) do { _Pragma("unroll") for (int _i = 0; _i < 2; ++_i) \
        __builtin_amdgcn_global_load_lds((const unsigned*)((const char*)(gbase) + (voff)[_i]), (PG8_LAS unsigned*)(lds + (bufoff) + ldsw + _i * 8192), 16, 0, 0); } while (0)
#define PG8_LDA(dst, b, h) do { _Pragma("unroll") for (int m = 0; m < 4; ++m) _Pragma("unroll") for (int k = 0; k < 2; ++k) dst[m][k] = *(const PG8_LAS bf16x8*)(lds + PG8_SA(b, h) + aoff + m * 2048 + k * 1024); } while (0)
#define PG8_LDB(dst, b, h) do { _Pragma("unroll") for (int n = 0; n < 2; ++n) _Pragma("unroll") for (int k = 0; k < 2; ++k) dst[n][k] = *(const PG8_LAS bf16x8*)(lds + PG8_SB(b, h) + boff + n * 2048 + k * 1024); } while (0)
#define PG8_MMA(ai, bj, At, Bt) do { __builtin_amdgcn_s_setprio(1); _Pragma("unroll") for (int m = 0; m < 4; ++m) _Pragma("unroll") for (int n = 0; n < 2; ++n) _Pragma("unroll") for (int k = 0; k < 2; ++k) \
        acc[ai][bj][m][n] = __builtin_amdgcn_mfma_f32_16x16x32_bf16(Bt[n][k], At[m][k], acc[ai][bj][m][n], 0, 0, 0); __builtin_amdgcn_s_setprio(0); } while (0)
#define PG8_WAIT_V(n) asm volatile("s_waitcnt vmcnt(" #n ")" ::: "memory")
#define PG8_WAIT_L(n) asm volatile("s_waitcnt lgkmcnt(" #n ")" ::: "memory")
#define PG8_BAR __builtin_amdgcn_s_barrier()
#define PG8_SCHED __builtin_amdgcn_sched_barrier(0)
    Unit cur, nxt; int ui = 0;
    if (!S.next(0, cur)) return;
    f32x4 acc[2][2][4][2];
#pragma unroll
    for (int a = 0; a < 2; ++a)
#pragma unroll
        for (int b = 0; b < 2; ++b)
#pragma unroll
            for (int m = 0; m < 4; ++m)
#pragma unroll
                for (int n = 0; n < 2; ++n) acc[a][b][m][n] = (f32x4){0.f, 0.f, 0.f, 0.f};
    bf16x8 At[4][2], B0[2][2], B1[2][2];
    const char* cA = (const char*)g.A + (size_t)cur.pm * tstep; const char* cB = (const char*)g.Bt + (size_t)cur.pn * tstep;
    S.a_ready(cur);
    if constexpr (SP2) {
        PG8_STAGE(PG8_SB(0, 0), cB, voffB); PG8_STAGE(PG8_SB(0, 1), cB + hstep, voffB); PG8_STAGE(PG8_SA(0, 0), cA, voffA); PG8_STAGE(PG8_SA(0, 1), cA + hstep, voffA);
        if (wr == 1) PG8_BAR;
        PG8_WAIT_V(2); PG8_BAR;
        PG8_STAGE(PG8_SB(1, 0), cB + kstep, voffB); PG8_STAGE(PG8_SA(1, 0), cA + kstep, voffA); PG8_STAGE(PG8_SB(1, 1), cB + hstep + kstep, voffB);
        PG8_WAIT_V(6); PG8_BAR;
    } else {
        PG8_STAGE(PG8_SB(0, 0), cB, voffB); PG8_STAGE(PG8_SA(0, 0), cA, voffA); PG8_STAGE(PG8_SB(0, 1), cB + hstep, voffB); PG8_STAGE(PG8_SA(0, 1), cA + hstep, voffA);
        if (wr == 1) PG8_BAR;
        PG8_WAIT_V(4); PG8_BAR;
        PG8_STAGE(PG8_SB(1, 0), cB + kstep, voffB); PG8_STAGE(PG8_SA(1, 0), cA + kstep, voffA); PG8_STAGE(PG8_SB(1, 1), cB + hstep + kstep, voffB);
        PG8_WAIT_V(6); PG8_BAR;
    }
    for (;;) {
        const bool has_next = S.next(ui + 1, nxt);
        const char* nA = has_next ? (const char*)g.A + (size_t)nxt.pm * tstep : cA; const char* nB = has_next ? (const char*)g.Bt + (size_t)nxt.pn * tstep : cB;
        for (int t = 0; t < nt; t += 2) {
            const bool last = (t == nt - 2);
            const char* a1 = cA + (size_t)(t + 1) * kstep;
            const char* a2 = last ? nA : cA + (size_t)(t + 2) * kstep; const char* b2 = last ? nB : cB + (size_t)(t + 2) * kstep;
            const char* a3 = a2 + kstep; const char* b3 = b2 + kstep;
            if (last && has_next) S.a_ready(nxt);
            if constexpr (SP2) {
            PG8_LDB(B0, 0, 0); PG8_LDB(B1, 0, 1); PG8_SCHED; PG8_LDA(At, 0, 0); PG8_STAGE(PG8_SA(1, 1), a1 + hstep, voffA);
            PG8_WAIT_V(8); PG8_WAIT_L(0); PG8_BAR; PG8_MMA(0, 0, At, B0); PG8_MMA(0, 1, At, B1); PG8_BAR; PG8_SCHED;
            PG8_LDA(At, 0, 1); PG8_STAGE(PG8_SB(0, 0), b2, voffB); PG8_STAGE(PG8_SB(0, 1), b2 + hstep, voffB); PG8_STAGE(PG8_SA(0, 0), a2, voffA);
            PG8_WAIT_V(8); PG8_WAIT_L(0); PG8_BAR; PG8_MMA(1, 0, At, B0); PG8_MMA(1, 1, At, B1); PG8_BAR; PG8_SCHED;
            PG8_LDB(B0, 1, 0); PG8_LDB(B1, 1, 1); PG8_SCHED; PG8_LDA(At, 1, 0); PG8_STAGE(PG8_SA(0, 1), a2 + hstep, voffA);
            PG8_WAIT_V(8); PG8_WAIT_L(0); PG8_BAR; PG8_MMA(0, 0, At, B0); PG8_MMA(0, 1, At, B1); PG8_BAR; PG8_SCHED;
            PG8_LDA(At, 1, 1); PG8_STAGE(PG8_SB(1, 0), b3, voffB); PG8_STAGE(PG8_SB(1, 1), b3 + hstep, voffB); PG8_STAGE(PG8_SA(1, 0), a3, voffA);
            PG8_WAIT_V(8); PG8_WAIT_L(0); PG8_BAR; PG8_MMA(1, 0, At, B0); PG8_MMA(1, 1, At, B1); PG8_BAR; PG8_SCHED;
            } else {
            PG8_LDB(B0, 0, 0); PG8_SCHED; PG8_LDA(At, 0, 0); PG8_STAGE(PG8_SA(1, 1), a1 + hstep, voffA);
            PG8_WAIT_L(8); PG8_BAR; PG8_WAIT_L(0); PG8_MMA(0, 0, At, B0); PG8_BAR; PG8_SCHED;
            PG8_LDB(B1, 0, 1); PG8_STAGE(PG8_SB(0, 0), b2, voffB);
            PG8_BAR; PG8_WAIT_L(0); PG8_MMA(0, 1, At, B1); PG8_BAR;
            PG8_LDA(At, 0, 1); PG8_STAGE(PG8_SA(0, 0), a2, voffA);
            PG8_BAR; PG8_WAIT_L(0); PG8_MMA(1, 0, At, B0); PG8_BAR; PG8_SCHED;
            PG8_STAGE(PG8_SB(0, 1), b2 + hstep, voffB);
            PG8_WAIT_V(6); PG8_BAR; PG8_MMA(1, 1, At, B1); PG8_BAR;
            PG8_LDB(B0, 1, 0); PG8_SCHED; PG8_LDA(At, 1, 0); PG8_STAGE(PG8_SA(0, 1), a2 + hstep, voffA);
            PG8_WAIT_L(8); PG8_BAR; PG8_WAIT_L(0); PG8_MMA(0, 0, At, B0); PG8_BAR; PG8_SCHED;
            PG8_LDB(B1, 1, 1); PG8_STAGE(PG8_SB(1, 0), b3, voffB);
            PG8_BAR; PG8_WAIT_L(0); PG8_MMA(0, 1, At, B1); PG8_BAR;
            PG8_LDA(At, 1, 1); PG8_STAGE(PG8_SA(1, 0), a3, voffA);
            PG8_BAR; PG8_WAIT_L(0); PG8_MMA(1, 0, At, B0); PG8_BAR; PG8_SCHED;
            PG8_STAGE(PG8_SB(1, 1), b3 + hstep, voffB);
            PG8_WAIT_V(6); PG8_BAR; PG8_MMA(1, 1, At, B1); PG8_BAR;
            }
        }
        if constexpr (ALIGN_EPI) { if (wr == 0) PG8_BAR; }
        if constexpr (!Epi::AFTER_DRAIN) { E(acc, cur, wr, wc, fr, fq); S.done(cur); }
        if (!has_next) break;
#pragma unroll
        for (int a = 0; a < 2; ++a)
#pragma unroll
            for (int b = 0; b < 2; ++b)
#pragma unroll
                for (int m = 0; m < 4; ++m)
#pragma unroll
                    for (int n = 0; n < 2; ++n) acc[a][b][m][n] = (f32x4){0.f, 0.f, 0.f, 0.f};
        cur = nxt; cA = nA; cB = nB; ++ui;
        if constexpr (ALIGN_EPI) { if (wr == 1) PG8_BAR; }
    }
    PG8_WAIT_V(0);
    if constexpr (!ALIGN_EPI) { if (wr == 0) PG8_BAR; }
    PG8_BAR;
    if constexpr (Epi::AFTER_DRAIN) { E.fused(acc, cur, wr, wc, fr, fq, lds, wid, lane); S.done(cur); }
#undef PG8_SA
#undef PG8_SB
#undef PG8_STAGE
#undef PG8_LDA
#undef PG8_LDB
#undef PG8_MMA
#undef PG8_WAIT_V
#undef PG8_WAIT_L
#undef PG8_BAR
#undef PG8_SCHED
}
}
#define GAS __attribute__((address_space(1)))
#define LAS __attribute__((address_space(3)))
typedef unsigned short bf16;
typedef unsigned v4u __attribute__((ext_vector_type(4)));
typedef unsigned v2u __attribute__((ext_vector_type(2)));
typedef float f32x4 __attribute__((ext_vector_type(4)));
typedef float f32x2 __attribute__((ext_vector_type(2)));
typedef float f32x16 __attribute__((ext_vector_type(16)));
typedef short bf16x8 __attribute__((ext_vector_type(8)));
typedef GAS unsigned gu32;
#define RLX_AGENT __ATOMIC_RELAXED, __HIP_MEMORY_SCOPE_AGENT
#define LDS_WAIT() asm volatile("s_waitcnt lgkmcnt(0)" ::: "memory")
#define VM_WAIT() asm volatile("s_waitcnt vmcnt(0)" ::: "memory")

constexpr int NWAVES = 8;
#ifndef MK_N_LAUNCHES
#define MK_N_LAUNCHES 1
#endif
constexpr int NPH = 15;
constexpr int N_LAUNCHES = MK_N_LAUNCHES;

constexpr int D = 1024, DIN = 1536, DFF = 4096, MTOK = 32768, NSEQ = 6, DEPTH = 2;
__device__ __forceinline__ int seq_tok0(int b) { return b < 2 ? b * 8192 : 16384 + (b - 2) * 4096; }
__device__ __forceinline__ int seq_len(int b) { return b < 2 ? 8192 : 4096; }

constexpr size_t MiB = 1u << 20, KiB = 1u << 10;
constexpr size_t WS_CTL = 0, CTL_ZERO_BYTES = 1 * MiB;
constexpr size_t WS_MOD = 1 * MiB;
constexpr size_t WS_VEC = 1 * MiB + 512 * KiB;
constexpr size_t WS_BIAS1 = 2 * MiB;
constexpr size_t WS_BIAS2 = 2 * MiB + 128 * KiB;
constexpr size_t WS_CL = 2 * MiB + 512 * KiB;
constexpr size_t WS_TW = 3 * MiB;
constexpr size_t WS_T1 = 3 * MiB + 128 * KiB;
constexpr size_t WS_T2 = 3 * MiB + 160 * KiB;
constexpr size_t WS_CSW = 3 * MiB + 256 * KiB;
constexpr size_t WS_WG = 4 * MiB;
constexpr size_t WS_AGG = 5 * MiB;
constexpr size_t WS_SS = 8 * MiB;
constexpr size_t WS_WIN = 16 * MiB;
constexpr size_t WS_WEFF = 22 * MiB;
constexpr size_t WS_WFF1 = 28 * MiB;
constexpr size_t WS_WFF2 = 44 * MiB;
constexpr size_t WS_A = 64 * MiB;
constexpr size_t WS_Z = 128 * MiB;
constexpr size_t WS_A2 = 224 * MiB;
constexpr size_t WS_H = 320 * MiB;
constexpr size_t WS_HMID = 128 * MiB;
constexpr size_t WS_END = 384 * MiB;
constexpr int CW_BAR = 4096;

constexpr int RING_OFF = 0, RING_BYTES = 131072;
constexpr int LDS_BYTES = 163840, MISC_OFF = LDS_BYTES - 256;
constexpr int L_WG = 0;
constexpr int L_PAR = 46080;
constexpr int L_AGG = 49152;
constexpr int L_CU = 57344;
constexpr int L_T1 = 59392;
constexpr int L_T2 = 77824;
constexpr int L_T2S = L_T2 + 128 * 136 * 2;
static_assert(L_T2S + 128 * 136 * 2 <= MISC_OFF, "LDS map");

#define XB_TMO      128
#define XB_XCNT(j)  (256  + 64 * (j))
#define XB_XSUB(j)  (1280 + 64 * (j))
#define XB_XGEN(j)  (2304 + 64 * (j))
#define XB_TOP      3328
#define XB_TOPGEN   3392
#define XCD_BAR_WORDS 3456
#define XB_SPIN_CAP (1u << 18)
__device__ __forceinline__ unsigned xb_ld(unsigned* p)              { return __hip_atomic_load(p, __ATOMIC_RELAXED, __HIP_MEMORY_SCOPE_AGENT); }
__device__ __forceinline__ unsigned xb_add(unsigned* p, unsigned v) { return __hip_atomic_fetch_add(p, v, __ATOMIC_RELAXED, __HIP_MEMORY_SCOPE_AGENT); }
__device__ __forceinline__ unsigned xb_xcc_id() { return (unsigned)__builtin_amdgcn_s_getreg((3 << 11) | 20) & 0xFu; }
#define XB_SPIN(cond, bar) do { unsigned _sp = 0; while (cond) { __builtin_amdgcn_s_sleep(1); \
    if ((++_sp & 255u) == 0u) { if (xb_ld(&(bar)[XB_TMO])) break; if (_sp > XB_SPIN_CAP) { atomicAdd(&(bar)[XB_TMO], 1u); break; } } } } while (0)
struct XcdBarrier { unsigned* bar; unsigned x; volatile LAS unsigned* st; };
__device__ __forceinline__ XcdBarrier xcd_barrier_post(unsigned* bar, volatile LAS unsigned* st) {
    XcdBarrier b; b.bar = bar; b.x = xb_xcc_id(); b.st = st;
    if (threadIdx.x == 0) (void)xb_add(&bar[XB_XCNT(b.x)], 1u);
    return b;
}
__device__ __forceinline__ void xcd_barrier_complete(unsigned* bar, unsigned x, unsigned& nloc, unsigned& nx) {
    const unsigned G = gridDim.x * gridDim.y * gridDim.z;
    unsigned sum, cnt, mine, sp = 0u;
    for (;;) {
        sum = 0u; cnt = 0u; mine = 0u;
#pragma unroll
        for (unsigned j = 0; j < 16; ++j) { const unsigned c = xb_ld(&bar[XB_XCNT(j)]); sum += c; cnt += (c > 0u) ? 1u : 0u; mine = (j == x) ? c : mine; }
        if (sum == G) break;
        __builtin_amdgcn_s_sleep(1);
        if ((++sp & 255u) == 0u) { if (xb_ld(&bar[XB_TMO])) break; if (sp > XB_SPIN_CAP) { atomicAdd(&bar[XB_TMO], 1u); break; } }
    }
    nloc = mine > 0u ? mine : 1u; nx = cnt > 0u ? cnt : 1u;
}
__device__ __forceinline__ void xcd_barrier(const XcdBarrier& b) {
    asm volatile("s_waitcnt vmcnt(0)" ::: "memory");
    __syncthreads();
    if (threadIdx.x == 0) {
        unsigned* bar = b.bar;
        __builtin_amdgcn_s_waitcnt(0);
        unsigned nloc = b.st[0], nx = b.st[1];
        if (nloc == 0u) { xcd_barrier_complete(bar, b.x, nloc, nx); b.st[0] = nloc; b.st[1] = nx; }
        const unsigned old = xb_add(&bar[XB_XSUB(b.x)], 1u);
        const unsigned gen = old / nloc;
        if (old + 1u == (gen + 1u) * nloc) {
            __builtin_amdgcn_fence(__ATOMIC_RELEASE, "agent");
            asm volatile("s_waitcnt vmcnt(0)" ::: "memory");
            const unsigned og = xb_add(&bar[XB_TOP], 1u);
            const unsigned tg = og / nx;
            if (og + 1u == (tg + 1u) * nx) xb_add(&bar[XB_TOPGEN], 1u);
            else XB_SPIN(xb_ld(&bar[XB_TOPGEN]) == tg, bar);
            __builtin_amdgcn_fence(__ATOMIC_ACQUIRE, "agent");
            xb_add(&bar[XB_XGEN(b.x)], 1u);
            asm volatile("s_waitcnt vmcnt(0)" ::: "memory");
        } else {
            XB_SPIN(xb_ld(&bar[XB_XGEN(b.x)]) == gen, bar);
            __builtin_amdgcn_fence(__ATOMIC_ACQUIRE, "agent");
            asm volatile("s_waitcnt vmcnt(0)" ::: "memory");
        }
    }
    __syncthreads();
}

__device__ __forceinline__ unsigned f2bf(float f) { unsigned u = __builtin_bit_cast(unsigned, f); return (u + 0x7fffu + ((u >> 16) & 1u)) >> 16; }
__device__ __forceinline__ unsigned pk2(float lo, float hi) { return f2bf(lo) | (f2bf(hi) << 16); }
__device__ __forceinline__ float bflo(unsigned w) { return __builtin_bit_cast(float, w << 16); }
__device__ __forceinline__ float bfhi(unsigned w) { return __builtin_bit_cast(float, w & 0xffff0000u); }
__device__ __forceinline__ float wave_sum(float v) {
#pragma unroll
    for (int o = 1; o < 64; o <<= 1) v += __shfl_xor(v, o);
    return v;
}
__device__ __forceinline__ float sigmoidf_fast(float x) { return __builtin_amdgcn_rcpf(1.0f + __builtin_amdgcn_exp2f(-1.44269504089f * x)); }

struct Frame {
    LAS unsigned char* lds;
    volatile LAS unsigned* MISC;
    gu32* ctl;
    int tid, lane, wave;
    int vcu, G;
    const float* in[21];
    float* out; unsigned char* ws;
};
enum { I_XP = 0, I_XS, I_CP, I_CS, I_GMIX, I_GMLP, I_WMOD, I_BMOD, I_WIN, I_WF, I_CONVW, I_CONVB, I_WRG, I_BRG, I_WIG, I_BIG, I_LAM, I_WOUT, I_WFF1, I_WFF2, I_GFIN };

__device__ __forceinline__ void p0_transpose_item(const float* W, int ldn, int nsub, bf16* WT, int ldd, int koff, int row_off, LAS float* scr, int item, int lane) {
    const int nblk = nsub / 32, kb = item / nblk, nb = item % nblk, k0 = 64 * kb, n0 = 32 * nb;
#pragma unroll 8
    for (int i = 0; i < 32; ++i) { const int kk = 2 * i + (lane >> 5); scr[kk * 33 + (lane & 31)] = W[(size_t)(k0 + kk) * ldn + n0 + (lane & 31)]; }
    LDS_WAIT(); asm volatile("" ::: "memory");
    const int c = lane & 7;
#pragma unroll
    for (int j = 0; j < 4; ++j) { const int n = (lane >> 3) + 8 * j; const LAS float* s = scr + (8 * c) * 33 + n;
        v4u o; o.x = pk2(s[0 * 33], s[1 * 33]); o.y = pk2(s[2 * 33], s[3 * 33]); o.z = pk2(s[4 * 33], s[5 * 33]); o.w = pk2(s[6 * 33], s[7 * 33]);
        *(GAS v4u*)(WT + (size_t)(row_off + n0 + n) * ldd + koff + k0 + 8 * c) = o; }
    LDS_WAIT(); asm volatile("" ::: "memory");
}
__device__ __forceinline__ void p0a(Frame& F) {
    const int tid = F.tid, lane = F.lane, wave = F.wave;
    {
        LAS float* sc = (LAS float*)(F.lds + 65536);
        LAS float* red = sc + 6144;
        for (int i = tid; i < 6144; i += NWAVES * 64) { const int b = i >> 10, k = i & 1023; const float v = b < 2 ? F.in[I_CP][b * 1024 + k] : F.in[I_CS][(b - 2) * 1024 + k]; sc[i] = v * sigmoidf_fast(v); }
        __syncthreads();
        float* MOD = (float*)(F.ws + WS_MOD);
        for (int item = F.vcu; item < 256; item += F.G) {
            const int gc = item * 48 + (lane < 48 ? lane : 0), l = gc / 6144, j = gc % 6144;
            float acc[6] = {0.f, 0.f, 0.f, 0.f, 0.f, 0.f};
            const float* wp = F.in[I_WMOD] + ((size_t)l * 1024 + wave * 128) * 6144 + j;
#pragma unroll 8
            for (int kk = 0; kk < 128; ++kk) { const float w = wp[(size_t)kk * 6144];
#pragma unroll
                for (int b = 0; b < 6; ++b) acc[b] += sc[b * 1024 + wave * 128 + kk] * w; }
            if (lane < 48) {
#pragma unroll
                for (int b = 0; b < 6; ++b) red[(wave * 6 + b) * 48 + lane] = acc[b]; }
            __syncthreads();
            if (tid < 288) { const int b = tid / 48, ln = tid % 48; float s = 0.f;
#pragma unroll
                for (int w = 0; w < 8; ++w) s += red[(w * 6 + b) * 48 + ln];
                const int gc2 = item * 48 + ln, l2 = gc2 / 6144, j2 = gc2 % 6144;
                MOD[((size_t)l2 * 6 + b) * 6144 + j2] = s + F.in[I_BMOD][l2 * 6144 + j2]; }
            __syncthreads();
        }
    }
    {
        LAS float* scr = (LAS float*)(F.lds + wave * 8704);
        const int gw = F.vcu * NWAVES + wave, NGW = F.G * NWAVES;
        constexpr int I_IN = 16 * 48, I_OUT = 8 * 32, I_F1 = 16 * 128, I_F2 = 64 * 32, PER_L = I_IN + I_OUT + I_F1 + I_F2;
        for (int it = gw; it < 2 * PER_L; it += NGW) {
            const int l = it / PER_L; int r = it % PER_L;
            if (r < I_IN) { p0_transpose_item(F.in[I_WIN] + (size_t)l * 1024 * 1536, 1536, 1536, (bf16*)(F.ws + WS_WIN) + (size_t)l * 1536 * 1024, 1024, 0, 0, scr, r, lane); continue; } r -= I_IN;
            if (r < I_OUT) { p0_transpose_item(F.in[I_WOUT] + (size_t)l * 1024 * 1024 + (size_t)512 * 1024, 1024, 1024, (bf16*)(F.ws + WS_WEFF) + (size_t)l * 1024 * 1536, 1536, 1024, 0, scr, r, lane); continue; } r -= I_OUT;
            if (r < I_F1) { p0_transpose_item(F.in[I_WFF1] + (size_t)l * 1024 * 4096, 4096, 4096, (bf16*)(F.ws + WS_WFF1) + (size_t)l * 4096 * 1024, 1024, 0, 0, scr, r, lane); continue; } r -= I_F1;
            p0_transpose_item(F.in[I_WFF2] + (size_t)l * 4096 * 1024, 1024, 1024, (bf16*)(F.ws + WS_WFF2) + (size_t)l * 1024 * 4096, 4096, 0, 0, scr, r, lane);
        }
    }
    {
        const int gt = F.vcu * (NWAVES * 64) + tid, GT = F.G * NWAVES * 64;
        bf16* T1 = (bf16*)(F.ws + WS_T1);
        for (int i = gt; i < 128 * 64; i += GT) { const int row = i >> 6, s1 = i & 63, k1 = row & 63, m = (k1 * s1) & 63; const float x = (float)m * (1.0f / 32.0f);
            T1[i] = (bf16)f2bf(row < 64 ? cospif(x) : -sinpif(x)); }
        bf16* T2 = (bf16*)(F.ws + WS_T2);
        for (int i = gt; i < 128 * 128; i += GT) { const int k2 = i >> 7, s2 = i & 127, m = (k2 * s2) & 127; const float x = (float)m * (1.0f / 64.0f);
            T2[i] = (bf16)f2bf(cospif(x)); T2[128 * 128 + i] = (bf16)f2bf(sinpif(x)); }
        f32x2* TW = (f32x2*)(F.ws + WS_TW);
        for (int i = gt; i < 128 * 64; i += GT) { const int s2 = i >> 6, k1 = i & 63, m = k1 * s2; const float x = (float)m * (1.0f / 4096.0f), sc = 0.011048543456039806f;
            TW[i] = (f32x2){cospif(x) * sc, sinpif(x) * sc}; }
        for (int i = gt; i < 64 * 64; i += GT) { const int s2 = i >> 6, k1 = i & 63, m = k1 * s2; const float x = (float)m * (1.0f / 2048.0f), sc = 0.015625f;
            TW[128 * 64 + i] = (f32x2){cospif(x) * sc, sinpif(x) * sc}; }
        float* CSW = (float*)(F.ws + WS_CSW);
        for (int i = gt; i < 2 * 8 * 2 * 4096; i += GT) { const int e = i & 63, d = (i >> 6) & 63, ty = (i >> 12) & 1, lh = i >> 13;
            const float* wf = F.in[I_WF] + (size_t)lh * 4096 + e; float s = 0.f;
            for (int m = 0; m < 64; ++m) { const float x = (float)((m * d) & 63) * (1.0f / 32.0f); s += (ty ? -sinpif(x) : cospif(x)) * wf[m * 64]; }
            CSW[i] = s * 0.125f; }
        bf16* WG = (bf16*)(F.ws + WS_WG);
        for (int i = gt; i < 2 * 8 * 320 * 64; i += GT) { const int k = i & 63, n = (i >> 6) % 320, lh = (i >> 6) / 320, l = lh >> 3, h = lh & 7; float v;
            if (n < 256) { const int g = n >> 6, e = n & 63, dir = g >> 1; const float* src = (g & 1) ? F.in[I_WIG] : F.in[I_WRG]; v = src[((size_t)((l * 2 + dir) * 8 + h) * 64 + k) * 64 + e]; }
            else v = (k == n - 256) ? 1.0f : 0.0f;
            WG[i] = (bf16)f2bf(v); }
        float* CL = (float*)(F.ws + WS_CL);
        for (int i = gt; i < 2 * 2 * 512; i += GT) { const float lam = F.in[I_LAM][i]; CL[i] = -8.0f * log1pf(expf(-lam)) * 1.44269504089f; }
    }
}

__device__ __forceinline__ void p0b(Frame& F) {
    const int tid = F.tid, lane = F.lane, wave = F.wave;
    const float* MOD = (const float*)(F.ws + WS_MOD);
    {
        LAS float* sh = (LAS float*)(F.lds + 65536);
        LAS float* red = sh + 6144;
        for (int item = F.vcu; item < 176; item += F.G) {
            const int l = item / 88, r = item % 88; const bool is1 = r < 24; const int n0 = (is1 ? r : r - 24) * 64, ldn = is1 ? 1536 : 4096, kind = is1 ? 0 : 3;
            __syncthreads();
            for (int i = tid; i < 6144; i += NWAVES * 64) { const int b = i >> 10, k = i & 1023; sh[i] = MOD[((size_t)l * 6 + b) * 6144 + kind * 1024 + k]; }
            __syncthreads();
            const float* wp = (is1 ? F.in[I_WIN] + (size_t)l * 1024 * 1536 : F.in[I_WFF1] + (size_t)l * 1024 * 4096) + (size_t)(wave * 128) * ldn + n0 + lane;
            float acc[6] = {0.f, 0.f, 0.f, 0.f, 0.f, 0.f};
#pragma unroll 8
            for (int kk = 0; kk < 128; ++kk) { const float w = wp[(size_t)kk * ldn];
#pragma unroll
                for (int b = 0; b < 6; ++b) acc[b] += sh[b * 1024 + wave * 128 + kk] * w; }
#pragma unroll
            for (int b = 0; b < 6; ++b) red[(wave * 6 + b) * 64 + lane] = acc[b];
            __syncthreads();
            if (tid < 384) { const int b = tid >> 6, ln = tid & 63; float s = 0.f;
#pragma unroll
                for (int w = 0; w < 8; ++w) s += red[(w * 6 + b) * 64 + ln];
                float* dst = is1 ? (float*)(F.ws + WS_BIAS1) + ((size_t)l * 6 + b) * 1536 : (float*)(F.ws + WS_BIAS2) + ((size_t)l * 6 + b) * 4096;
                dst[n0 + ln] = s; }
        }
        __syncthreads();
    }
    {
        LAS float* wo = (LAS float*)(F.lds);
        LAS float* cw = wo + 4096;
        LAS float* sw = cw + 4096;
        const float* CSW = (const float*)(F.ws + WS_CSW);
        for (int item = F.vcu; item < 256; item += F.G) {
            const int nb = item & 15, h = (item >> 4) & 7, l = item >> 7;
            __syncthreads();
            for (int i = tid; i < 4096; i += NWAVES * 64) { const int e = i >> 6, n = i & 63;
                wo[i] = F.in[I_WOUT][(size_t)l * 1024 * 1024 + (size_t)(h * 64 + e) * 1024 + nb * 64 + n];
                cw[i] = CSW[((size_t)(l * 8 + h) * 2 + 0) * 4096 + i]; sw[i] = CSW[((size_t)(l * 8 + h) * 2 + 1) * 4096 + i]; }
            __syncthreads();
            const int n = tid & 63, d0 = (tid >> 6) * 8;
            float aw[8], bw[8];
#pragma unroll
            for (int j = 0; j < 8; ++j) { aw[j] = 0.f; bw[j] = 0.f; }
            for (int e = 0; e < 64; ++e) { const float w = wo[e * 64 + n];
#pragma unroll
                for (int j = 0; j < 8; ++j) { aw[j] += cw[(d0 + j) * 64 + e] * w; bw[j] += sw[(d0 + j) * 64 + e] * w; } }
            bf16* dst = (bf16*)(F.ws + WS_WEFF) + (size_t)l * 1024 * 1536 + (size_t)(nb * 64 + n) * 1536 + h * 64 + d0;
            v4u oa, ob; oa.x = pk2(aw[0], aw[1]); oa.y = pk2(aw[2], aw[3]); oa.z = pk2(aw[4], aw[5]); oa.w = pk2(aw[6], aw[7]);
            ob.x = pk2(bw[0], bw[1]); ob.y = pk2(bw[2], bw[3]); ob.z = pk2(bw[4], bw[5]); ob.w = pk2(bw[6], bw[7]);
            *(GAS v4u*)(dst) = oa; *(GAS v4u*)(dst + 512) = ob;
        }
        __syncthreads();
    }
    {
        const int gt = F.vcu * (NWAVES * 64) + tid, GT = F.G * NWAVES * 64;
        float* VEC = (float*)(F.ws + WS_VEC);
        for (int i = gt; i < 2 * 6 * 4 * 1024; i += GT) { const int k = i & 1023, kind = (i >> 10) & 3, lb = i >> 12, l = lb / 6; const float* m = MOD + (size_t)lb * 6144; float v;
            if (kind == 0) v = F.in[I_GMIX][l * 1024 + k] * (1.0f + m[1024 + k]);
            else if (kind == 1) v = m[2048 + k];
            else if (kind == 2) v = F.in[I_GMLP][l * 1024 + k] * (1.0f + m[4096 + k]);
            else v = m[5120 + k];
            VEC[i] = v; }
    }
    {
        const int gw = F.vcu * NWAVES + wave, NGW = F.G * NWAVES;
        bf16* A = (bf16*)(F.ws + WS_A); float* SS = (float*)(F.ws + WS_SS);
        for (int row = gw; row < MTOK; row += NGW) {
            const int b = pg8::seq_of_row(row);
            const float* xr = row < 16384 ? F.in[I_XP] + (size_t)row * 1024 : F.in[I_XS] + (size_t)(row - 16384) * 1024;
            const float* sc1 = MOD + (size_t)b * 6144 + 1024;
            f32x4 v[4]; float s = 0.f;
#pragma unroll
            for (int j = 0; j < 4; ++j) { v[j] = *(const f32x4*)(xr + 4 * lane + 256 * j); s += (v[j][0] * v[j][0] + v[j][1] * v[j][1]) + (v[j][2] * v[j][2] + v[j][3] * v[j][3]); }
            s = wave_sum(s);
#pragma unroll
            for (int j = 0; j < 4; ++j) { const f32x4 g = *(const f32x4*)(F.in[I_GMIX] + 4 * lane + 256 * j), sc = *(const f32x4*)(sc1 + 4 * lane + 256 * j);
                const f32x4 a = v[j] * (g * (1.0f + sc));
                v2u o; o.x = pk2(a[0], a[1]); o.y = pk2(a[2], a[3]);
                *(GAS v2u*)(A + (size_t)row * 1024 + 4 * lane + 256 * j) = o; }
            if (lane < 16) SS[(size_t)row * 16 + lane] = lane == 0 ? s : 0.f;
        }
    }
}

__device__ __forceinline__ void final_norm(Frame& F) {
    const int gw = F.vcu * NWAVES + F.wave, NGW = F.G * NWAVES, lane = F.lane;
    const float* SS = (const float*)(F.ws + WS_SS);
    for (int row = gw; row < MTOK; row += NGW) {
        const float r = pg8::row_rscale(SS, row);
        float* xr = F.out + (size_t)row * 1024;
#pragma unroll
        for (int j = 0; j < 4; ++j) { const f32x4 v = *(const f32x4*)(xr + 4 * lane + 256 * j), g = *(const f32x4*)(F.in[I_GFIN] + 4 * lane + 256 * j);
            *(f32x4*)(xr + 4 * lane + 256 * j) = v * r * g; }
    }
}
__device__ __forceinline__ void load_wg_tables(Frame& F, int l, int h) {
    const bf16* WG = (const bf16*)(F.ws + WS_WG) + (size_t)(l * 8 + h) * 320 * 64;
    for (int i = F.tid; i < 320 * 8; i += NWAVES * 64) { const int n = i >> 3, c = i & 7; *(LAS v4u*)(F.lds + L_WG + n * 144 + c * 16) = *(const GAS v4u*)(WG + n * 64 + c * 8); }
    LAS float* par = (LAS float*)(F.lds + L_PAR);
    for (int i = F.tid; i < 11 * 64; i += NWAVES * 64) { const int p = i >> 6, c = i & 63, ch = h * 64 + c; float v;
        if (p < 4) v = F.in[I_CONVW][(size_t)l * 4 * 512 + p * 512 + ch];
        else if (p == 4) v = F.in[I_CONVB][l * 512 + ch];
        else if (p == 5) v = F.in[I_BRG][(l * 2 + 0) * 512 + ch];
        else if (p == 6) v = F.in[I_BIG][(l * 2 + 0) * 512 + ch];
        else if (p == 7) v = F.in[I_BRG][(l * 2 + 1) * 512 + ch];
        else if (p == 8) v = F.in[I_BIG][(l * 2 + 1) * 512 + ch];
        else if (p == 9) v = ((const float*)(F.ws + WS_CL))[(l * 2 + 0) * 512 + ch];
        else v = ((const float*)(F.ws + WS_CL))[(l * 2 + 1) * 512 + ch];
        par[i] = v; }
}
__device__ __forceinline__ void load_t1(Frame& F) {
    const bf16* T1 = (const bf16*)(F.ws + WS_T1);
    for (int i = F.tid; i < 128 * 8; i += NWAVES * 64) { const int r = i >> 3, c = i & 7; *(LAS v4u*)(F.lds + L_T1 + r * 144 + c * 16) = *(const GAS v4u*)(T1 + r * 64 + c * 8); }
}
__device__ __forceinline__ void load_t2(Frame& F) {
    const bf16* T2 = (const bf16*)(F.ws + WS_T2);
    for (int i = F.tid; i < 2 * 128 * 16; i += NWAVES * 64) { const int t = i >> 11, r = (i >> 4) & 127, c = i & 15; *(LAS v4u*)(F.lds + (t ? L_T2S : L_T2) + r * 272 + c * 16) = *(const GAS v4u*)(T2 + (size_t)t * 16384 + r * 128 + c * 8); }
}

template <bool FINAL>
__device__ __forceinline__ void lru_unit(Frame& F, int b, int h, int jseq, int jslot) {
    int lane = F.lane; asm volatile("" : "+v"(lane));
    const int w = F.wave, q = lane & 31, hh = lane >> 5;
    const int tokS = seq_tok0(b), S = seq_len(b);
    const int tw0 = tokS + 256 * jseq + 32 * w;
    const LAS unsigned char* Wg = F.lds + L_WG; const LAS float* par = (const LAS float*)(F.lds + L_PAR);
    LAS float* agg = (LAS float*)(F.lds + L_AGG); const LAS float* cu = (const LAS float*)(F.lds + L_CU);
    const bf16* Z = (const bf16*)(F.ws + WS_Z);
    bf16x8 Af[4];
    {
        const int t = tw0 + q;
        const bf16* zr = Z + (size_t)t * DIN + 512 + h * 64;
#pragma unroll
        for (int ks = 0; ks < 4; ++ks) {
            const int c0 = 16 * ks + 8 * hh;
            float a8[8];
            { const f32x4 b0 = *(const LAS f32x4*)(par + 4 * 64 + c0), b1 = *(const LAS f32x4*)(par + 4 * 64 + c0 + 4);
              a8[0] = b0[0]; a8[1] = b0[1]; a8[2] = b0[2]; a8[3] = b0[3]; a8[4] = b1[0]; a8[5] = b1[1]; a8[6] = b1[2]; a8[7] = b1[3]; }
#pragma unroll
            for (int kk = 0; kk < 4; ++kk) {
                const int tt = t - 2 + kk; const bool valid = (tt >= tokS) && (tt < tokS + S);
                v4u raw = (v4u){0u, 0u, 0u, 0u};
                if (valid) raw = *(const GAS v4u*)(zr + (ptrdiff_t)(kk - 2) * DIN + c0);
                const f32x4 w0 = *(const LAS f32x4*)(par + kk * 64 + c0), w1 = *(const LAS f32x4*)(par + kk * 64 + c0 + 4);
                a8[0] += bflo(raw.x) * w0[0]; a8[1] += bfhi(raw.x) * w0[1]; a8[2] += bflo(raw.y) * w0[2]; a8[3] += bfhi(raw.y) * w0[3];
                a8[4] += bflo(raw.z) * w1[0]; a8[5] += bfhi(raw.z) * w1[1]; a8[6] += bflo(raw.w) * w1[2]; a8[7] += bfhi(raw.w) * w1[3];
            }
            v4u pk; pk.x = pk2(a8[0], a8[1]); pk.y = pk2(a8[2], a8[3]); pk.z = pk2(a8[4], a8[5]); pk.w = pk2(a8[6], a8[7]);
            Af[ks] = __builtin_bit_cast(bf16x8, pk);
            __builtin_amdgcn_sched_barrier(0);
        }
    }
#pragma unroll 1
    for (int e2 = 0; e2 < 2; ++e2) {
        f32x16 acc[5];
#pragma unroll
        for (int g = 0; g < 5; ++g)
#pragma unroll
            for (int i = 0; i < 16; ++i) acc[g][i] = 0.f;
#pragma unroll
        for (int ks = 0; ks < 4; ++ks)
#pragma unroll
            for (int g = 0; g < 5; ++g) { const int n = (g < 4 ? g * 64 : 256) + e2 * 32 + q;
                const bf16x8 Bf = *(const LAS bf16x8*)(Wg + n * 144 + (16 * ks + 8 * hh) * 2);
                acc[g] = __builtin_amdgcn_mfma_f32_32x32x16_bf16(Af[ks], Bf, acc[g], 0, 0, 0);
                if (g == 4) __builtin_amdgcn_sched_barrier(0); }
        const int c = e2 * 32 + q;
        const float brf = par[5 * 64 + c], bif = par[6 * 64 + c], brb = par[7 * 64 + c], bib = par[8 * 64 + c], clf = par[9 * 64 + c], clb = par[10 * 64 + c];
#pragma unroll
        for (int i = 0; i < 16; ++i) {
            const float uc = acc[4][i];
            const float rf = sigmoidf_fast(acc[0][i] + brf), gi = sigmoidf_fast(acc[1][i] + bif);
            const float af = __builtin_amdgcn_exp2f(clf * rf);
            acc[0][i] = af; acc[1][i] = __builtin_amdgcn_sqrtf(fmaxf(1.0f - af * af, 0.f)) * gi * uc;
            const float rb = sigmoidf_fast(acc[2][i] + brb), gib = sigmoidf_fast(acc[3][i] + bib);
            const float ab = __builtin_amdgcn_exp2f(clb * rb);
            acc[2][i] = ab; acc[3][i] = __builtin_amdgcn_sqrtf(fmaxf(1.0f - ab * ab, 0.f)) * gib * uc;
            if ((i & 3) == 3) __builtin_amdgcn_sched_barrier(0);
        }
        float Pg[4], Hg[4], oP[4], oH[4];
#pragma unroll
        for (int g = 0; g < 4; ++g) { float hs = 0.f, p = 1.f;
#pragma unroll
            for (int r = 0; r < 4; ++r) { const int i = 4 * g + r; hs = acc[0][i] * hs + acc[1][i]; p *= acc[0][i]; acc[1][i] = hs; acc[0][i] = p; }
            Pg[g] = p; Hg[g] = hs; oP[g] = __shfl_xor(p, 32); oH[g] = __shfl_xor(hs, 32); }
        __builtin_amdgcn_sched_barrier(0);
        float cg0f[4], ppf[4], Pwf, Hwf;
        { float cc = 0.f, pp = 1.f;
#pragma unroll
            for (int g = 0; g < 4; ++g) { const float Pl = hh ? oP[g] : Pg[g], Hl = hh ? oH[g] : Hg[g], Ph = hh ? Pg[g] : oP[g], Hh = hh ? Hg[g] : oH[g];
                const float c_lo = cc, p_lo = pp; cc = Pl * cc + Hl; pp *= Pl;
                const float c_hi = cc, p_hi = pp; cc = Ph * cc + Hh; pp *= Ph;
                cg0f[g] = hh ? c_hi : c_lo; ppf[g] = hh ? p_hi : p_lo; }
            Pwf = pp; Hwf = cc; }
        __builtin_amdgcn_sched_barrier(0);
#pragma unroll
        for (int g = 0; g < 4; ++g) { float hs = 0.f, p = 1.f;
#pragma unroll
            for (int r = 3; r >= 0; --r) { const int i = 4 * g + r; hs = acc[2][i] * hs + acc[3][i]; p *= acc[2][i]; acc[3][i] = hs; acc[2][i] = p; }
            Pg[g] = p; Hg[g] = hs; oP[g] = __shfl_xor(p, 32); oH[g] = __shfl_xor(hs, 32); }
        __builtin_amdgcn_sched_barrier(0);
        float cg0b[4], ppb[4], Pwb, Hwb;
        { float cc = 0.f, pp = 1.f;
#pragma unroll
            for (int g = 3; g >= 0; --g) { const float Pl = hh ? oP[g] : Pg[g], Hl = hh ? oH[g] : Hg[g], Ph = hh ? Pg[g] : oP[g], Hh = hh ? Hg[g] : oH[g];
                const float c_hi = cc, p_hi = pp; cc = Ph * cc + Hh; pp *= Ph;
                const float c_lo = cc, p_lo = pp; cc = Pl * cc + Hl; pp *= Pl;
                cg0b[g] = hh ? c_hi : c_lo; ppb[g] = hh ? p_hi : p_lo; }
            Pwb = pp; Hwb = cc; }
        __builtin_amdgcn_sched_barrier(0);
        if (hh == 0) { *(LAS f32x2*)(agg + (((e2 * 8 + w) * 2 + 0) * 32 + q) * 2) = (f32x2){Pwf, Hwf}; *(LAS f32x2*)(agg + (((e2 * 8 + w) * 2 + 1) * 32 + q) * 2) = (f32x2){Pwb, Hwb}; }
        if (FINAL) {
            __syncthreads();
            float cf = cu[(jslot * 2 + 0) * 64 + c], cb = cu[(jslot * 2 + 1) * 64 + c];
            for (int ww = 0; ww < w; ++ww) { const f32x2 a = *(const LAS f32x2*)(agg + (((e2 * 8 + ww) * 2 + 0) * 32 + q) * 2); cf = a.x * cf + a.y; }
            for (int ww = 7; ww > w; --ww) { const f32x2 a = *(const LAS f32x2*)(agg + (((e2 * 8 + ww) * 2 + 1) * 32 + q) * 2); cb = a.x * cb + a.y; }
            const bf16* ug = Z + (size_t)tw0 * DIN + 1024 + h * 64 + c;
            bf16* yo = (bf16*)(F.ws + WS_A2) + (size_t)tw0 * DIN + 1024 + h * 64 + c;
#pragma unroll
            for (int g = 0; g < 4; ++g) {
                const float carf = cg0f[g] + ppf[g] * cf, carb = cg0b[g] + ppb[g] * cb;
#pragma unroll
                for (int r = 0; r < 4; ++r) { const int i = 4 * g + r, tok = r + 8 * g + 4 * hh;
                    const float hf = acc[1][i] + acc[0][i] * carf, hb = acc[3][i] + acc[2][i] * carb;
                    const float x = bflo((unsigned)ug[(size_t)tok * DIN]);
                    const float y2 = 1.5957691216f * (x + 0.044715f * x * x * x);
                    const float ge = x * sigmoidf_fast(y2);
                    yo[(size_t)tok * DIN] = (bf16)f2bf((hf + hb) * ge); }
                __builtin_amdgcn_sched_barrier(0);
            }
        }
    }
    if (!FINAL) {
        __syncthreads();
        if (F.tid < 128) { const int dir = F.tid >> 6, c = F.tid & 63, e2 = c >> 5, qq = c & 31; float P = 1.f, H = 0.f;
            if (dir == 0) { for (int ww = 0; ww < 8; ++ww) { const f32x2 a = *(const LAS f32x2*)(agg + (((e2 * 8 + ww) * 2 + 0) * 32 + qq) * 2); H = a.x * H + a.y; P *= a.x; } }
            else { for (int ww = 7; ww >= 0; --ww) { const f32x2 a = *(const LAS f32x2*)(agg + (((e2 * 8 + ww) * 2 + 1) * 32 + qq) * 2); H = a.x * H + a.y; P *= a.x; } }
            float* AGG = (float*)(F.ws + WS_AGG);
            *(f32x2*)(AGG + ((((size_t)(b * 8 + h) * 32 + jseq) * 2 + dir) * 64 + c) * 2) = (f32x2){P, H}; }
    }
    __syncthreads();
}
template <bool FINAL>
__device__ __forceinline__ void lru_phase(Frame& F, int l) {
#pragma unroll 1
    for (int v = F.vcu; v < 256; v += F.G) {
        const int h = v >> 5, rg = v & 31, tok = rg * 1024, b = pg8::seq_of_row(tok), j0 = (tok - seq_tok0(b)) >> 8, nch = seq_len(b) >> 8;
        { int t_ = F.tid; asm volatile("" : "+v"(t_)); F.tid = t_; F.lane = t_ & 63; }
        __syncthreads();
        load_wg_tables(F, l, h);
        if (FINAL && F.tid < 128) {
            const int dir = F.tid >> 6, c = F.tid & 63; LAS float* cu = (LAS float*)(F.lds + L_CU);
            const float* AGG = (const float*)(F.ws + WS_AGG) + (size_t)(b * 8 + h) * 32 * 256;
            float cc = 0.f;
            if (dir == 0) { for (int j = 0; j < j0 + 4; ++j) { if (j >= j0) cu[((j - j0) * 2 + 0) * 64 + c] = cc; const f32x2 a = *(const f32x2*)(AGG + ((size_t)(j * 2 + 0) * 64 + c) * 2); cc = a.x * cc + a.y; } }
            else { for (int j = nch - 1; j >= j0; --j) { if (j < j0 + 4) cu[((j - j0) * 2 + 1) * 64 + c] = cc; const f32x2 a = *(const f32x2*)(AGG + ((size_t)(j * 2 + 1) * 64 + c) * 2); cc = a.x * cc + a.y; } }
        }
        __syncthreads();
#pragma unroll 1
        for (int jj = 0; jj < 4; ++jj) lru_unit<FINAL>(F, b, h, j0 + jj, jj);
    }
}

__device__ __forceinline__ unsigned perm_lo(unsigned a, unsigned b) { return __builtin_amdgcn_perm(b, a, 0x05040100u); }
__device__ __forceinline__ unsigned perm_hi(unsigned a, unsigned b) { return __builtin_amdgcn_perm(b, a, 0x07060302u); }
__device__ __forceinline__ void make_bfrags(const v2u (&X)[8], bf16x8 (&Bf)[4]) {
#pragma unroll
    for (int jp = 0; jp < 4; ++jp) { v4u o;
        const unsigned a0 = (jp >> 1) ? X[0].y : X[0].x, a1 = (jp >> 1) ? X[1].y : X[1].x, a2 = (jp >> 1) ? X[2].y : X[2].x, a3 = (jp >> 1) ? X[3].y : X[3].x;
        const unsigned a4 = (jp >> 1) ? X[4].y : X[4].x, a5 = (jp >> 1) ? X[5].y : X[5].x, a6 = (jp >> 1) ? X[6].y : X[6].x, a7 = (jp >> 1) ? X[7].y : X[7].x;
        if (jp & 1) { o.x = perm_hi(a0, a1); o.y = perm_hi(a2, a3); o.z = perm_hi(a4, a5); o.w = perm_hi(a6, a7); }
        else { o.x = perm_lo(a0, a1); o.y = perm_lo(a2, a3); o.z = perm_lo(a4, a5); o.w = perm_lo(a6, a7); }
        Bf[jp] = __builtin_bit_cast(bf16x8, o); }
}
__device__ __forceinline__ void dft1_unit(Frame& F, int b, int s2, int cg) {
    int lane = F.lane; asm volatile("" : "+v"(lane));
    const int q = lane & 15, g = lane >> 4;
    const int tokS = seq_tok0(b), N2 = seq_len(b) >> 6;
    const bf16* Z = (const bf16*)(F.ws + WS_Z) + (size_t)(tokS + s2) * DIN + cg * 64 + 4 * q;
    pg8::f32x4 acc[8][4];
#pragma unroll
    for (int mt = 0; mt < 8; ++mt)
#pragma unroll
        for (int jp = 0; jp < 4; ++jp) acc[mt][jp] = (pg8::f32x4){0.f, 0.f, 0.f, 0.f};
#pragma unroll
    for (int ks = 0; ks < 2; ++ks) {
        v2u X[8];
#pragma unroll
        for (int i = 0; i < 8; ++i) X[i] = *(const GAS v2u*)(Z + (size_t)(32 * ks + 8 * g + i) * N2 * DIN);
        bf16x8 Bf[4]; make_bfrags(X, Bf);
#pragma unroll
        for (int mt = 0; mt < 8; ++mt) { const bf16x8 Afr = *(const LAS bf16x8*)(F.lds + L_T1 + (16 * mt + q) * 144 + (32 * ks + 8 * g) * 2);
#pragma unroll
            for (int jp = 0; jp < 4; ++jp) acc[mt][jp] = __builtin_amdgcn_mfma_f32_16x16x32_bf16(Afr, Bf[jp], acc[mt][jp], 0, 0, 0); }
    }
    const f32x2* TW = (const f32x2*)(F.ws + WS_TW) + (N2 == 128 ? 0 : 128 * 64) + (size_t)s2 * 64;
    bf16* Hb = (bf16*)(F.ws + WS_H) + (size_t)tokS * 1024 + cg * 64 + 4 * q;
#pragma unroll
    for (int mt = 0; mt < 4; ++mt)
#pragma unroll
        for (int r = 0; r < 4; ++r) { const int k1 = 16 * mt + 4 * g + r; const f32x2 t = TW[k1];
            float hr[4], hi[4];
#pragma unroll
            for (int jp = 0; jp < 4; ++jp) { const float a = acc[mt][jp][r], bb = acc[mt + 4][jp][r]; hr[jp] = a * t.x + bb * t.y; hi[jp] = bb * t.x - a * t.y; }
            v2u o; o.x = pk2(hr[0], hr[1]); o.y = pk2(hr[2], hr[3]);
            *(GAS v2u*)(Hb + ((size_t)(k1 * 2 + 0) * N2 + s2) * 512) = o;
            o.x = pk2(hi[0], hi[1]); o.y = pk2(hi[2], hi[3]);
            *(GAS v2u*)(Hb + ((size_t)(k1 * 2 + 1) * N2 + s2) * 512) = o; }
}
__device__ __forceinline__ void dft1_phase(Frame& F) {
    const int gw = F.vcu * NWAVES + F.wave, NGW = F.G * NWAVES;
#pragma unroll 1
    for (int id = gw; id < 4096; id += NGW) {
        int b, s2, cg;
        if (id < 2048) { b = id >> 10; const int rem = id & 1023; s2 = rem >> 3; cg = rem & 7; }
        else { const int i2 = id - 2048; b = 2 + (i2 >> 9); const int rem = i2 & 511; s2 = rem >> 3; cg = rem & 7; }
        dft1_unit(F, b, s2, cg);
    }
}
__device__ __forceinline__ void dft2_unit(Frame& F, int b, int k1, int cg, int mh) {
    int lane = F.lane; asm volatile("" : "+v"(lane));
    const int q = lane & 15, g = lane >> 4;
    const int tokS = seq_tok0(b), N2 = seq_len(b) >> 6, rs = 128 / N2;
    const bf16* Hb = (const bf16*)(F.ws + WS_H) + (size_t)tokS * 1024 + (size_t)k1 * 2 * N2 * 512 + cg * 64 + 4 * q;
    pg8::f32x4 acc[8][4];
#pragma unroll
    for (int mt = 0; mt < 8; ++mt)
#pragma unroll
        for (int jp = 0; jp < 4; ++jp) acc[mt][jp] = (pg8::f32x4){0.f, 0.f, 0.f, 0.f};
    const int nks = (2 * N2) >> 5;
#pragma unroll 1
    for (int ks = 0; ks < nks; ++ks) {
        v2u X[8];
#pragma unroll
        for (int i = 0; i < 8; ++i) X[i] = *(const GAS v2u*)(Hb + (size_t)(32 * ks + 8 * g + i) * 512);
        bf16x8 Bf[4]; make_bfrags(X, Bf);
        const int kk0 = 32 * ks + 8 * g, ri = kk0 >= N2 ? 1 : 0, s20 = kk0 - ri * N2;
#pragma unroll
        for (int mt = 0; mt < 8; ++mt) {
            const int R = 128 * mh + 16 * mt + q, ty = R >= N2 ? 1 : 0, k2 = R - ty * N2;
            const bool useC = (ty == ri), neg = (ty == 1) && (ri == 1);
            v4u a = *(const LAS v4u*)(F.lds + (useC ? L_T2 : L_T2S) + (k2 * rs) * 272 + s20 * 2);
            if (neg) { a.x ^= 0x80008000u; a.y ^= 0x80008000u; a.z ^= 0x80008000u; a.w ^= 0x80008000u; }
            const bf16x8 Afr = __builtin_bit_cast(bf16x8, a);
#pragma unroll
            for (int jp = 0; jp < 4; ++jp) acc[mt][jp] = __builtin_amdgcn_mfma_f32_16x16x32_bf16(Afr, Bf[jp], acc[mt][jp], 0, 0, 0); }
    }
    bf16* A2 = (bf16*)(F.ws + WS_A2) + (size_t)tokS * DIN + cg * 64 + 4 * q;
#pragma unroll
    for (int mt = 0; mt < 8; ++mt)
#pragma unroll
        for (int r = 0; r < 4; ++r) { const int R = 128 * mh + 16 * mt + 4 * g + r, ty = R >= N2 ? 1 : 0, k2 = R - ty * N2, k = k1 + 64 * k2;
            v2u o; o.x = pk2(acc[mt][0][r], acc[mt][1][r]); o.y = pk2(acc[mt][2][r], acc[mt][3][r]);
            *(GAS v2u*)(A2 + (size_t)k * DIN + ty * 512) = o; }
}
__device__ __forceinline__ void dft2_phase(Frame& F) {
    const int gw = F.vcu * NWAVES + F.wave, NGW = F.G * NWAVES;
#pragma unroll 1
    for (int id = gw; id < 2048; id += NGW) {
        const int b = id >> 10, rem = id & 1023; dft2_unit(F, b, rem >> 4, (rem >> 1) & 7, rem & 1); }
#pragma unroll 1
    for (int id = gw; id < 2048; id += NGW) {
        const int b = 2 + (id >> 9), rem = id & 511; dft2_unit(F, b, rem >> 3, rem & 7, 0); }
}
struct Args { const float* in[21]; float* out; unsigned char* ws; int ph_lo, ph_hi; };
__global__ void __launch_bounds__(NWAVES * 64, 2) mk_fwd(Args args) {
    extern __shared__ __attribute__((aligned(16))) unsigned char lds[];
    Frame F;
    F.lds = (LAS unsigned char*)lds;
    F.MISC = (volatile LAS unsigned*)(F.lds + MISC_OFF);
    F.tid = threadIdx.x; F.lane = F.tid & 63; F.wave = __builtin_amdgcn_readfirstlane(F.tid >> 6);
    F.G = gridDim.x; { const int bx = blockIdx.x; F.vcu = (F.G % 8 == 0) ? (bx % 8) * (F.G / 8) + bx / 8 : bx; }
#pragma unroll
    for (int i = 0; i < 21; ++i) F.in[i] = args.in[i];
    F.out = args.out; F.ws = args.ws; F.ctl = (gu32*)(args.ws + WS_CTL);
    if (F.tid < 64) ((LAS unsigned*)(F.lds + MISC_OFF))[F.tid] = 0u;
    __syncthreads();
    XcdBarrier bar; bar.bar = (unsigned*)(F.ctl + CW_BAR); bar.x = 0; bar.st = nullptr;
    if (N_LAUNCHES == 1) bar = xcd_barrier_post((unsigned*)(F.ctl + CW_BAR), F.MISC + 8);
    const int lo = args.ph_lo, hi = args.ph_hi;
#define IN(k) (lo <= (k) && (k) < hi)
#define SEAM(k) do { if (IN(k) && IN((k) + 1)) xcd_barrier(bar); } while (0)

    #ifndef NO_P0A
    if (IN(0)) { p0a(F); }
#endif
    SEAM(0);
    #ifndef NO_P0B
    if (IN(1)) { p0b(F); }
#endif
    SEAM(1);
    float* SS = (float*)(F.ws + WS_SS);
    const float* VEC = (const float*)(F.ws + WS_VEC);
#pragma unroll 1
    for (int l = 0; l < DEPTH; ++l) {
        const int pb = 2 + 6 * l;
#define REFRESH() do { int t_ = F.tid; asm volatile("" : "+v"(t_)); F.tid = t_; F.lane = t_ & 63; F.wave = __builtin_amdgcn_readfirstlane(t_ >> 6); } while (0)
#ifndef NO_G1
        if (IN(pb + 0)) { REFRESH();
            pg8::Gemm g{(const pg8::bf16_t*)(F.ws + WS_A), (const pg8::bf16_t*)(F.ws + WS_WIN) + (size_t)l * 1536 * 1024, MTOK, DIN, D};
            pg8::StaticOrder S; S.init(MTOK, DIN, F.G, (int)blockIdx.x);
            pg8::EpiScaleBias<0> E{(pg8::bf16_t*)(F.ws + WS_Z), DIN, SS, (const float*)(F.ws + WS_BIAS1) + (size_t)l * 6 * 1536};
            pg8::gemm_phase<pg8::EpiScaleBias<0>, pg8::StaticOrder, true, true>(F.lds + RING_OFF, g, S, E, F.tid);
        }
#endif
        SEAM(pb + 0);
#ifndef NO_M1
        if (IN(pb + 1)) { REFRESH();
            __syncthreads();
            load_t1(F);
#ifndef NO_LRU
            lru_phase<false>(F, l);
#endif
#ifndef NO_DFT
            dft1_phase(F);
#endif
        }
#endif
        SEAM(pb + 1);
#ifndef NO_M2
        if (IN(pb + 2)) { REFRESH();
            __syncthreads();
            load_t2(F);
#ifndef NO_LRU
            lru_phase<true>(F, l);
#endif
#ifndef NO_DFT
            dft2_phase(F);
#endif
        }
#endif
        SEAM(pb + 2);
#ifndef NO_G2
        if (IN(pb + 3)) { REFRESH();
            pg8::Gemm g{(const pg8::bf16_t*)(F.ws + WS_A2), (const pg8::bf16_t*)(F.ws + WS_WEFF) + (size_t)l * 1024 * 1536, MTOK, D, DIN};
            pg8::StaticOrder S; S.init(MTOK, D, F.G, (int)blockIdx.x);
            pg8::EpiResidual E{l == 0 ? F.in[I_XP] : (const float*)F.out, l == 0 ? F.in[I_XS] : (const float*)F.out + (size_t)16384 * 1024, F.out, (pg8::bf16_t*)(F.ws + WS_A), SS,
                               VEC + (size_t)l * 6 * 4096 + 1 * 1024, VEC + (size_t)l * 6 * 4096 + 2 * 1024};
            pg8::gemm_phase<pg8::EpiResidual, pg8::StaticOrder, true, true>(F.lds + RING_OFF, g, S, E, F.tid);
        }
#endif
        SEAM(pb + 3);
#ifndef NO_G3
        if (IN(pb + 4)) { REFRESH();
            pg8::Gemm g{(const pg8::bf16_t*)(F.ws + WS_A), (const pg8::bf16_t*)(F.ws + WS_WFF1) + (size_t)l * 4096 * 1024, MTOK, DFF, D};
            pg8::StaticOrder S; S.init(MTOK, DFF, F.G, (int)blockIdx.x);
            pg8::EpiScaleBias<1> E{(pg8::bf16_t*)(F.ws + WS_HMID), DFF, SS, (const float*)(F.ws + WS_BIAS2) + (size_t)l * 6 * 4096};
            pg8::gemm_phase<pg8::EpiScaleBias<1>, pg8::StaticOrder, true, true>(F.lds + RING_OFF, g, S, E, F.tid);
        }
#endif
        SEAM(pb + 4);
#ifndef NO_G4
        if (IN(pb + 5)) { REFRESH();
            pg8::Gemm g{(const pg8::bf16_t*)(F.ws + WS_HMID), (const pg8::bf16_t*)(F.ws + WS_WFF2) + (size_t)l * 1024 * 4096, MTOK, D, DFF};
            pg8::StaticOrder S; S.init(MTOK, D, F.G, (int)blockIdx.x);
            const int ln = l + 1 < DEPTH ? l + 1 : l;
            pg8::EpiResidual E{(const float*)F.out, (const float*)F.out + (size_t)16384 * 1024, F.out, l + 1 < DEPTH ? (pg8::bf16_t*)(F.ws + WS_A) : (pg8::bf16_t*)nullptr, SS,
                               VEC + (size_t)l * 6 * 4096 + 3 * 1024, VEC + (size_t)ln * 6 * 4096 + 0 * 1024};
            pg8::gemm_phase<pg8::EpiResidual, pg8::StaticOrder, true, true>(F.lds + RING_OFF, g, S, E, F.tid);
        }
#endif
        SEAM(pb + 5);
    }
    if (IN(14)) { REFRESH(); final_norm(F); }
#undef IN
#undef SEAM
}

extern "C" void kernel_launch(void* const* d_in, const int* in_sizes, int n_in, void* d_out, int out_size, void* d_ws, size_t ws_size, hipStream_t stream) {
    static int grid = 0;
    if (grid == 0) {
        if (n_in != 21 || out_size != MTOK * D || ws_size < WS_END) { fprintf(stderr, "kernel_launch: built for 21 inputs, %d outputs, >= %zu bytes of workspace; got %d, %d, %zu; nothing launched\n", MTOK * D, (size_t)WS_END, n_in, out_size, ws_size); grid = -1; return; }
        int dev = 0, cus = 0, per_cu = 0;
        if (hipGetDevice(&dev) != hipSuccess || hipDeviceGetAttribute(&cus, hipDeviceAttributeMultiprocessorCount, dev) != hipSuccess) { fprintf(stderr, "kernel_launch: device query failed\n"); grid = -1; return; }
        if (hipFuncSetAttribute((const void*)mk_fwd, hipFuncAttributeMaxDynamicSharedMemorySize, LDS_BYTES) != hipSuccess) { fprintf(stderr, "kernel_launch: hipFuncSetAttribute failed\n"); grid = -1; return; }
        if (hipOccupancyMaxActiveBlocksPerMultiprocessor(&per_cu, (const void*)mk_fwd, NWAVES * 64, LDS_BYTES) != hipSuccess || per_cu < 1) { fprintf(stderr, "kernel_launch: occupancy query reports %d workgroups per CU; nothing launched\n", per_cu); (void)hipGetLastError(); grid = -1; return; }
        (void)hipGetLastError();
        grid = cus;
    }
    if (grid < 0) return;
    (void)hipMemsetAsync((char*)d_ws + WS_CTL, 0, CTL_ZERO_BYTES, stream);
    Args a{};
    for (int i = 0; i < 21; ++i) a.in[i] = (const float*)d_in[i];
    a.out = (float*)d_out; a.ws = (unsigned char*)d_ws;
    if (N_LAUNCHES == 1) { a.ph_lo = 0; a.ph_hi = NPH; hipLaunchKernelGGL(mk_fwd, dim3(grid), dim3(NWAVES * 64), LDS_BYTES, stream, a); }
    else for (int p = 0; p < NPH; ++p) { a.ph_lo = p; a.ph_hi = p + 1; hipLaunchKernelGGL(mk_fwd, dim3(grid), dim3(NWAVES * 64), LDS_BYTES, stream, a); }
}
```

```cpp
#include <hip/hip_runtime.h>
#include <cstdio>
#include <cstdint>
#include <cstddef>
namespace pg8 {
#define PG8_LAS __attribute__((address_space(3)))
typedef unsigned short bf16_t;
typedef short bf16x8 __attribute__((ext_vector_type(8)));
typedef float f32x4 __attribute__((ext_vector_type(4)));
typedef unsigned u32x4 __attribute__((ext_vector_type(4)));
constexpr int BM = 256, BK = 64, HALF = 128, HTB = HALF * BK * 2  , STAGE_BYTES = 8 * HTB, NXCD = 8, WGM = 8;

__host__ __device__ __forceinline__ int lds_byte(int r, int c) { const int st = (r >> 4) * 2 + (c >> 5), rr = r & 15, cc = c & 31, ob = rr * 64 + cc * 2; return st * 1024 + (ob ^ (((ob >> 9) & 1) << 5)); }
__host__ __device__ __forceinline__ void stage_rc(int b, int& R, int& C) { const int st = b / 1024, sb = b % 1024, swz = sb ^ (((sb >> 9) & 1) << 5); R = (st >> 1) * 16 + swz / 64; C = (st & 1) * 32 + (swz % 64) / 2; }
__host__ __device__ __forceinline__ int perm32(int rho) { const int n = rho >> 4, i = rho & 15; return 8 * (i >> 2) + 4 * n + (i & 3); }

struct Unit { int pm, pn; };
struct Gemm { const bf16_t* A; const bf16_t* Bt; int M, N, K; };

struct StaticOrder {
    int nM, nN, nwg, G, c;
    __host__ __device__ void init(int M, int N, int G_, int c_) { nM = M / BM; nN = N / BM; nwg = nM * nN; G = G_; c = c_; }
    __host__ __device__ bool next(int i, Unit& u) const {
        const long L = (long)i * G + c; if (L >= nwg) return false;
        int wgid = (int)L; { const int q = nwg / NXCD, r = nwg % NXCD, xcd = wgid % NXCD, off = wgid / NXCD; wgid = (xcd < r ? xcd * (q + 1) : r * (q + 1) + (xcd - r) * q) + off; }
        const int nig = WGM * nN, gid = wgid / nig, fm = gid * WGM, gsz = (nM - fm) < WGM ? (nM - fm) : WGM;
        u.pm = fm + ((wgid % nig) % gsz); u.pn = (wgid % nig) / gsz; return true;
    }
    __device__ __forceinline__ void a_ready(const Unit&) const {}
    __device__ __forceinline__ void done(const Unit&) const {}
};

__device__ __forceinline__ unsigned cvt_pk_bf16(float lo, float hi) { unsigned r; asm volatile("v_cvt_pk_bf16_f32 %0, %1, %2" : "=v"(r) : "v"(lo), "v"(hi)); return r; }
__device__ __forceinline__ int seq_of_row(int row) { return row < 16384 ? (row >> 13) : 2 + ((row - 16384) >> 12); }
constexpr int SS_SLOTS = 16;
__device__ __forceinline__ float row_rscale(const float* ss, int row) {
    const f32x4* p = (const f32x4*)(ss + (size_t)row * SS_SLOTS);
    f32x4 a = p[0], b = p[1], c = p[2], d = p[3];
    a = (a + b) + (c + d);
    const float s = (a[0] + a[1]) + (a[2] + a[3]);
    return __builtin_amdgcn_rsqf(s * (1.0f / 1024.0f) + 1e-6f);
}
template <int ACT> struct EpiScaleBias {
    static constexpr bool PERM = true, AFTER_DRAIN = false;
    bf16_t* O; int ldc; const float* ss; const float* bias;
    __device__ __forceinline__ void operator()(const f32x4 (&acc)[2][2][4][2], const Unit& u, int wr, int wc, int fr, int fq) const {
        const int row0 = u.pm * BM + wr * 64 + fr, col0 = u.pn * BM + wc * 32 + 8 * fq;
        const int b = seq_of_row(u.pm * BM);
        const float* bp = bias + (size_t)b * ldc + col0;
        f32x4 bv[2][2];
#pragma unroll
        for (int bj = 0; bj < 2; ++bj)
#pragma unroll
            for (int n = 0; n < 2; ++n) bv[bj][n] = *(const f32x4*)(bp + bj * HALF + 4 * n);
#pragma unroll
        for (int ai = 0; ai < 2; ++ai)
#pragma unroll
            for (int m = 0; m < 4; ++m) { const int row = row0 + ai * HALF + m * 16; const float r = row_rscale(ss, row);
                bf16_t* rowp = O + (size_t)row * ldc + col0;
#pragma unroll
                for (int bj = 0; bj < 2; ++bj) { f32x4 v0 = acc[ai][bj][m][0] * r + bv[bj][0], v1 = acc[ai][bj][m][1] * r + bv[bj][1];
                    if (ACT == 1) {
#pragma unroll
                        for (int j = 0; j < 4; ++j) { const float a0 = fmaxf(v0[j], 0.f), a1 = fmaxf(v1[j], 0.f); v0[j] = a0 * a0; v1[j] = a1 * a1; } }
                    u32x4 w; w.x = cvt_pk_bf16(v0[0], v0[1]); w.y = cvt_pk_bf16(v0[2], v0[3]); w.z = cvt_pk_bf16(v1[0], v1[1]); w.w = cvt_pk_bf16(v1[2], v1[3]);
                    *(u32x4*)(rowp + bj * HALF) = w; } }
    }
};
struct EpiResidual {
    static constexpr bool PERM = true, AFTER_DRAIN = false;
    const float* xin0; const float* xin1;
    float* xout; bf16_t* An; float* ss; const float* gate; const float* alpha;
    __device__ __forceinline__ void operator()(const f32x4 (&acc)[2][2][4][2], const Unit& u, int wr, int wc, int fr, int fq) const {
        const int row0 = u.pm * BM + wr * 64 + fr, col0 = u.pn * BM + wc * 32 + 8 * fq;
        const int b = seq_of_row(u.pm * BM);
        f32x4 gv[2][2], av[2][2];
#pragma unroll
        for (int bj = 0; bj < 2; ++bj)
#pragma unroll
            for (int n = 0; n < 2; ++n) { gv[bj][n] = *(const f32x4*)(gate + (size_t)b * 4096 + col0 + bj * HALF + 4 * n); av[bj][n] = *(const f32x4*)(alpha + (size_t)b * 4096 + col0 + bj * HALF + 4 * n); }
#pragma unroll
        for (int ai = 0; ai < 2; ++ai)
#pragma unroll
            for (int m = 0; m < 4; ++m) { const int row = row0 + ai * HALF + m * 16;
                const float* xr = (row < 16384 ? xin0 + (size_t)row * 1024 : xin1 + (size_t)(row - 16384) * 1024) + col0;
                float* xo = xout + (size_t)row * 1024 + col0;
                float sp = 0.f;
#pragma unroll
                for (int bj = 0; bj < 2; ++bj) {
                    const f32x4 x0 = *(const f32x4*)(xr + bj * HALF), x1 = *(const f32x4*)(xr + bj * HALF + 4);
                    const f32x4 y0 = x0 + gv[bj][0] * acc[ai][bj][m][0], y1 = x1 + gv[bj][1] * acc[ai][bj][m][1];
                    *(f32x4*)(xo + bj * HALF) = y0; *(f32x4*)(xo + bj * HALF + 4) = y1;
                    sp += (y0[0] * y0[0] + y0[1] * y0[1]) + (y0[2] * y0[2] + y0[3] * y0[3]) + (y1[0] * y1[0] + y1[1] * y1[1]) + (y1[2] * y1[2] + y1[3] * y1[3]);
                    if (An) { const f32x4 a0 = y0 * av[bj][0], a1 = y1 * av[bj][1];
                        u32x4 w; w.x = cvt_pk_bf16(a0[0], a0[1]); w.y = cvt_pk_bf16(a0[2], a0[3]); w.z = cvt_pk_bf16(a1[0], a1[1]); w.w = cvt_pk_bf16(a1[2], a1[3]);
                        *(u32x4*)(An + (size_t)row * 1024 + col0 + bj * HALF) = w; } }
                sp += __shfl_xor(sp, 16); sp += __shfl_xor(sp, 32);
                if (fq == 0) ss[(size_t)row * SS_SLOTS + u.pn * 4 + wc] = sp; }
    }
};
template <class Epi, class Sched, bool ALIGN_EPI = false, bool SP2 = false>
__device__ __forceinline__ void gemm_phase(PG8_LAS unsigned char* lds, const Gemm g, const Sched& S, const Epi& E, const int tid) {
    const int wid = __builtin_amdgcn_readfirstlane(tid >> 6), lane = tid & 63, wr = wid >> 2, wc = wid & 3, fr = lane & 15, fq = lane >> 4;
    const int K = g.K, nt = K / BK;
    unsigned voffA[2], voffB[2];
#pragma unroll
    for (int i = 0; i < 2; ++i) { int R, C; stage_rc(tid * 16 + i * 8192, R, C); const int Rb = Epi::PERM ? ((R & ~31) + perm32(R & 31)) : R;
        voffA[i] = (unsigned)(R * K + C) * 2u; voffB[i] = (unsigned)(Rb * K + C) * 2u; }
    const size_t kstep = (size_t)(BK * 2);
    const size_t hstep = (size_t)HALF * K * 2;
    const size_t tstep = 2 * hstep;
    const unsigned ldsw = (unsigned)wid * 1024u;
    const int aoff = lds_byte(wr * 64 + fr, fq * 8), boff = lds_byte(wc * 32 + fr, fq * 8);
#define PG8_SA(b, h) (((b) * 2 + (h)) * HTB)
#define PG8_SB(b, h) ((4 + (b) * 2 + (h)) * HTB)
#define PG8_STAGE(bufoff, gbase, voff) do { _Pragma("unroll") for (int _i = 0; _i < 2; ++_i) \
        __builtin_amdgcn_global_load_lds((const unsigned*)((const char*)(gbase) + (voff)[_i]), (PG8_LAS unsigned*)(lds + (bufoff) + ldsw + _i * 8192), 16, 0, 0); } while (0)
#define PG8_LDA(dst, b, h) do { _Pragma("unroll") for (int m = 0; m < 4; ++m) _Pragma("unroll") for (int k = 0; k < 2; ++k) dst[m][k] = *(const PG8_LAS bf16x8*)(lds + PG8_SA(b, h) + aoff + m * 2048 + k * 1024); } while (0)
#define PG8_LDB(dst, b, h) do { _Pragma("unroll") for (int n = 0; n < 2; ++n) _Pragma("unroll") for (int k = 0; k < 2; ++k) dst[n][k] = *(const PG8_LAS bf16x8*)(lds + PG8_SB(b, h) + boff + n * 2048 + k * 1024); } while (0)
#define PG8_MMA(ai, bj, At, Bt) do { __builtin_amdgcn_s_setprio(1); _Pragma("unroll") for (int m = 0; m < 4; ++m) _Pragma("unroll") for (int n = 0; n < 2; ++n) _Pragma("unroll") for (int k = 0; k < 2; ++k) \
        acc[ai][bj][m][n] = __builtin_amdgcn_mfma_f32_16x16x32_bf16(Bt[n][k], At[m][k], acc[ai][bj][m][n], 0, 0, 0); __builtin_amdgcn_s_setprio(0); } while (0)
#define PG8_WAIT_V(n) asm volatile("s_waitcnt vmcnt(" #n ")" ::: "memory")
#define PG8_WAIT_L(n) asm volatile("s_waitcnt lgkmcnt(" #n ")" ::: "memory")
#define PG8_BAR __builtin_amdgcn_s_barrier()
#define PG8_SCHED __builtin_amdgcn_sched_barrier(0)
    Unit cur, nxt; int ui = 0;
    if (!S.next(0, cur)) return;
    f32x4 acc[2][2][4][2];
#pragma unroll
    for (int a = 0; a < 2; ++a)
#pragma unroll
        for (int b = 0; b < 2; ++b)
#pragma unroll
            for (int m = 0; m < 4; ++m)
#pragma unroll
                for (int n = 0; n < 2; ++n) acc[a][b][m][n] = (f32x4){0.f, 0.f, 0.f, 0.f};
    bf16x8 At[4][2], B0[2][2], B1[2][2];
    const char* cA = (const char*)g.A + (size_t)cur.pm * tstep; const char* cB = (const char*)g.Bt + (size_t)cur.pn * tstep;
    S.a_ready(cur);
    if constexpr (SP2) {
        PG8_STAGE(PG8_SB(0, 0), cB, voffB); PG8_STAGE(PG8_SB(0, 1), cB + hstep, voffB); PG8_STAGE(PG8_SA(0, 0), cA, voffA); PG8_STAGE(PG8_SA(0, 1), cA + hstep, voffA);
        if (wr == 1) PG8_BAR;
        PG8_WAIT_V(2); PG8_BAR;
        PG8_STAGE(PG8_SB(1, 0), cB + kstep, voffB); PG8_STAGE(PG8_SA(1, 0), cA + kstep, voffA); PG8_STAGE(PG8_SB(1, 1), cB + hstep + kstep, voffB);
        PG8_WAIT_V(6); PG8_BAR;
    } else {
        PG8_STAGE(PG8_SB(0, 0), cB, voffB); PG8_STAGE(PG8_SA(0, 0), cA, voffA); PG8_STAGE(PG8_SB(0, 1), cB + hstep, voffB); PG8_STAGE(PG8_SA(0, 1), cA + hstep, voffA);
        if (wr == 1) PG8_BAR;
        PG8_WAIT_V(4); PG8_BAR;
        PG8_STAGE(PG8_SB(1, 0), cB + kstep, voffB); PG8_STAGE(PG8_SA(1, 0), cA + kstep, voffA); PG8_STAGE(PG8_SB(1, 1), cB + hstep + kstep, voffB);
        PG8_WAIT_V(6); PG8_BAR;
    }
    for (;;) {
        const bool has_next = S.next(ui + 1, nxt);
        const char* nA = has_next ? (const char*)g.A + (size_t)nxt.pm * tstep : cA; const char* nB = has_next ? (const char*)g.Bt + (size_t)nxt.pn * tstep : cB;
        for (int t = 0; t < nt; t += 2) {
            const bool last = (t == nt - 2);
            const char* a1 = cA + (size_t)(t + 1) * kstep;
            const char* a2 = last ? nA : cA + (size_t)(t + 2) * kstep; const char* b2 = last ? nB : cB + (size_t)(t + 2) * kstep;
            const char* a3 = a2 + kstep; const char* b3 = b2 + kstep;
            if (last && has_next) S.a_ready(nxt);
            if constexpr (SP2) {
            PG8_LDB(B0, 0, 0); PG8_LDB(B1, 0, 1); PG8_SCHED; PG8_LDA(At, 0, 0); PG8_STAGE(PG8_SA(1, 1), a1 + hstep, voffA);
            PG8_WAIT_V(8); PG8_WAIT_L(0); PG8_BAR; PG8_MMA(0, 0, At, B0); PG8_MMA(0, 1, At, B1); PG8_BAR; PG8_SCHED;
            PG8_LDA(At, 0, 1); PG8_STAGE(PG8_SB(0, 0), b2, voffB); PG8_STAGE(PG8_SB(0, 1), b2 + hstep, voffB); PG8_STAGE(PG8_SA(0, 0), a2, voffA);
            PG8_WAIT_V(8); PG8_WAIT_L(0); PG8_BAR; PG8_MMA(1, 0, At, B0); PG8_MMA(1, 1, At, B1); PG8_BAR; PG8_SCHED;
            PG8_LDB(B0, 1, 0); PG8_LDB(B1, 1, 1); PG8_SCHED; PG8_LDA(At, 1, 0); PG8_STAGE(PG8_SA(0, 1), a2 + hstep, voffA);
            PG8_WAIT_V(8); PG8_WAIT_L(0); PG8_BAR; PG8_MMA(0, 0, At, B0); PG8_MMA(0, 1, At, B1); PG8_BAR; PG8_SCHED;
            PG8_LDA(At, 1, 1); PG8_STAGE(PG8_SB(1, 0), b3, voffB); PG8_STAGE(PG8_SB(1, 1), b3 + hstep, voffB); PG8_STAGE(PG8_SA(1, 0), a3, voffA);
            PG8_WAIT_V(8); PG8_WAIT_L(0); PG8_BAR; PG8_MMA(1, 0, At, B0); PG8_MMA(1, 1, At, B1); PG8_BAR; PG8_SCHED;
            } else {
            PG8_LDB(B0, 0, 0); PG8_SCHED; PG8_LDA(At, 0, 0); PG8_STAGE(PG8_SA(1, 1), a1 + hstep, voffA);
            PG8_WAIT_L(8); PG8_BAR; PG8_WAIT_L(0); PG8_MMA(0, 0, At, B0); PG8_BAR; PG8_SCHED;
            PG8_LDB(B1, 0, 1); PG8_STAGE(PG8_SB(0, 0), b2, voffB);
            PG8_BAR; PG8_WAIT_L(0); PG8_MMA(0, 1, At, B1); PG8_BAR;
            PG8_LDA(At, 0, 1); PG8_STAGE(PG8_SA(0, 0), a2, voffA);
            PG8_BAR; PG8_WAIT_L(0); PG8_MMA(1, 0, At, B0); PG8_BAR; PG8_SCHED;
            PG8_STAGE(PG8_SB(0, 1), b2 + hstep, voffB);
            PG8_WAIT_V(6); PG8_BAR; PG8_MMA(1, 1, At, B1); PG8_BAR;
            PG8_LDB(B0, 1, 0); PG8_SCHED; PG8_LDA(At, 1, 0); PG8_STAGE(PG8_SA(0, 1), a2 + hstep, voffA);
            PG8_WAIT_L(8); PG8_BAR; PG8_WAIT_L(0); PG8_MMA(0, 0, At, B0); PG8_BAR; PG8_SCHED;
            PG8_LDB(B1, 1, 1); PG8_STAGE(PG8_SB(1, 0), b3, voffB);
            PG8_BAR; PG8_WAIT_L(0); PG8_MMA(0, 1, At, B1); PG8_BAR;
            PG8_LDA(At, 1, 1); PG8_STAGE(PG8_SA(1, 0), a3, voffA);
            PG8_BAR; PG8_WAIT_L(0); PG8_MMA(1, 0, At, B0); PG8_BAR; PG8_SCHED;
            PG8_STAGE(PG8_SB(1, 1), b3 + hstep, voffB);
            PG8_WAIT_V(6); PG8_BAR; PG8_MMA(1, 1, At, B1); PG8_BAR;
            }
        }
        if constexpr (ALIGN_EPI) { if (wr == 0) PG8_BAR; }
        if constexpr (!Epi::AFTER_DRAIN) { E(acc, cur, wr, wc, fr, fq); S.done(cur); }
        if (!has_next) break;
#pragma unroll
        for (int a = 0; a < 2; ++a)
#pragma unroll
            for (int b = 0; b < 2; ++b)
#pragma unroll
                for (int m = 0; m < 4; ++m)
#pragma unroll
                    for (int n = 0; n < 2; ++n) acc[a][b][m][n] = (f32x4){0.f, 0.f, 0.f, 0.f};
        cur = nxt; cA = nA; cB = nB; ++ui;
        if constexpr (ALIGN_EPI) { if (wr == 1) PG8_BAR; }
    }
    PG8_WAIT_V(0);
    if constexpr (!ALIGN_EPI) { if (wr == 0) PG8_BAR; }
    PG8_BAR;
    if constexpr (Epi::AFTER_DRAIN) { E.fused(acc, cur, wr, wc, fr, fq, lds, wid, lane); S.done(cur); }
#undef PG8_SA
#undef PG8_SB
#undef PG8_STAGE
#undef PG8_LDA
#undef PG8_LDB
#undef PG8_MMA
#undef PG8_WAIT_V
#undef PG8_WAIT_L
#undef PG8_BAR
#undef PG8_SCHED
}
}
#define GAS __attribute__((address_space(1)))
#define LAS __attribute__((address_space(3)))
typedef unsigned short bf16;
typedef unsigned v4u __attribute__((ext_vector_type(4)));
typedef unsigned v2u __attribute__((ext_vector_type(2)));
typedef float f32x4 __attribute__((ext_vector_type(4)));
typedef float f32x2 __attribute__((ext_vector_type(2)));
typedef float f32x16 __attribute__((ext_vector_type(16)));
typedef short bf16x8 __attribute__((ext_vector_type(8)));
typedef GAS unsigned gu32;
#define RLX_AGENT __ATOMIC_RELAXED, __HIP_MEMORY_SCOPE_AGENT
#define LDS_WAIT() asm volatile("s_waitcnt lgkmcnt(0)" ::: "memory")
#define VM_WAIT() asm volatile("s_waitcnt vmcnt(0)" ::: "memory")

constexpr int NWAVES = 8;
#ifndef MK_N_LAUNCHES
#define MK_N_LAUNCHES 1
#endif
constexpr int NPH = 15;
constexpr int N_LAUNCHES = MK_N_LAUNCHES;

constexpr int D = 1024, DIN = 1536, DFF = 4096, MTOK = 32768, NSEQ = 6, DEPTH = 2;
__device__ __forceinline__ int seq_tok0(int b) { return b < 2 ? b * 8192 : 16384 + (b - 2) * 4096; }
__device__ __forceinline__ int seq_len(int b) { return b < 2 ? 8192 : 4096; }

constexpr size_t MiB = 1u << 20, KiB = 1u << 10;
constexpr size_t WS_CTL = 0, CTL_ZERO_BYTES = 1 * MiB;
constexpr size_t WS_MOD = 1 * MiB;
constexpr size_t WS_VEC = 1 * MiB + 512 * KiB;
constexpr size_t WS_BIAS1 = 2 * MiB;
constexpr size_t WS_BIAS2 = 2 * MiB + 128 * KiB;
constexpr size_t WS_CL = 2 * MiB + 512 * KiB;
constexpr size_t WS_TW = 3 * MiB;
constexpr size_t WS_T1 = 3 * MiB + 128 * KiB;
constexpr size_t WS_T2 = 3 * MiB + 160 * KiB;
constexpr size_t WS_CSW = 3 * MiB + 256 * KiB;
constexpr size_t WS_WG = 4 * MiB;
constexpr size_t WS_AGG = 5 * MiB;
constexpr size_t WS_SS = 8 * MiB;
constexpr size_t WS_WIN = 16 * MiB;
constexpr size_t WS_WEFF = 22 * MiB;
constexpr size_t WS_WFF1 = 28 * MiB;
constexpr size_t WS_WFF2 = 44 * MiB;
constexpr size_t WS_A = 64 * MiB;
constexpr size_t WS_Z = 128 * MiB;
constexpr size_t WS_A2 = 224 * MiB;
constexpr size_t WS_H = 320 * MiB;
constexpr size_t WS_HMID = 128 * MiB;
constexpr size_t WS_END = 384 * MiB;
constexpr int CW_BAR = 4096;

constexpr int RING_OFF = 0, RING_BYTES = 131072;
constexpr int LDS_BYTES = 163840, MISC_OFF = LDS_BYTES - 256;
constexpr int L_WG = 0;
constexpr int L_PAR = 46080;
constexpr int L_AGG = 49152;
constexpr int L_CU = 57344;
constexpr int L_T1 = 59392;
constexpr int L_T2 = 77824;
constexpr int L_T2S = L_T2 + 128 * 136 * 2;
constexpr int L_STREAM = L_T2;
constexpr int L_YT = L_T2 + 32768;
static_assert(L_YT + 8 * 4608 <= L_T2 + 2 * 128 * 136 * 2, "LRU scratch inside the T2 region");
static_assert(L_T2S + 128 * 136 * 2 <= MISC_OFF, "LDS map");

#define XB_TMO      128
#define XB_XCNT(j)  (256  + 64 * (j))
#define XB_XSUB(j)  (1280 + 64 * (j))
#define XB_XGEN(j)  (2304 + 64 * (j))
#define XB_TOP      3328
#define XB_TOPGEN   3392
#define XCD_BAR_WORDS 3456
#define XB_SPIN_CAP (1u << 18)
__device__ __forceinline__ unsigned xb_ld(unsigned* p)              { return __hip_atomic_load(p, __ATOMIC_RELAXED, __HIP_MEMORY_SCOPE_AGENT); }
__device__ __forceinline__ unsigned xb_add(unsigned* p, unsigned v) { return __hip_atomic_fetch_add(p, v, __ATOMIC_RELAXED, __HIP_MEMORY_SCOPE_AGENT); }
__device__ __forceinline__ unsigned xb_xcc_id() { return (unsigned)__builtin_amdgcn_s_getreg((3 << 11) | 20) & 0xFu; }
#define XB_SPIN(cond, bar) do { unsigned _sp = 0; while (cond) { __builtin_amdgcn_s_sleep(1); \
    if ((++_sp & 255u) == 0u) { if (xb_ld(&(bar)[XB_TMO])) break; if (_sp > XB_SPIN_CAP) { atomicAdd(&(bar)[XB_TMO], 1u); break; } } } } while (0)
struct XcdBarrier { unsigned* bar; unsigned x; volatile LAS unsigned* st; };
__device__ __forceinline__ XcdBarrier xcd_barrier_post(unsigned* bar, volatile LAS unsigned* st) {
    XcdBarrier b; b.bar = bar; b.x = xb_xcc_id(); b.st = st;
    if (threadIdx.x == 0) (void)xb_add(&bar[XB_XCNT(b.x)], 1u);
    return b;
}
__device__ __forceinline__ void xcd_barrier_complete(unsigned* bar, unsigned x, unsigned& nloc, unsigned& nx) {
    const unsigned G = gridDim.x * gridDim.y * gridDim.z;
    unsigned sum, cnt, mine, sp = 0u;
    for (;;) {
        sum = 0u; cnt = 0u; mine = 0u;
#pragma unroll
        for (unsigned j = 0; j < 16; ++j) { const unsigned c = xb_ld(&bar[XB_XCNT(j)]); sum += c; cnt += (c > 0u) ? 1u : 0u; mine = (j == x) ? c : mine; }
        if (sum == G) break;
        __builtin_amdgcn_s_sleep(1);
        if ((++sp & 255u) == 0u) { if (xb_ld(&bar[XB_TMO])) break; if (sp > XB_SPIN_CAP) { atomicAdd(&bar[XB_TMO], 1u); break; } }
    }
    nloc = mine > 0u ? mine : 1u; nx = cnt > 0u ? cnt : 1u;
}
__device__ __forceinline__ void xcd_barrier(const XcdBarrier& b) {
    asm volatile("s_waitcnt vmcnt(0)" ::: "memory");
    __syncthreads();
    if (threadIdx.x == 0) {
        unsigned* bar = b.bar;
        __builtin_amdgcn_s_waitcnt(0);
        unsigned nloc = b.st[0], nx = b.st[1];
        if (nloc == 0u) { xcd_barrier_complete(bar, b.x, nloc, nx); b.st[0] = nloc; b.st[1] = nx; }
        const unsigned old = xb_add(&bar[XB_XSUB(b.x)], 1u);
        const unsigned gen = old / nloc;
        if (old + 1u == (gen + 1u) * nloc) {
            __builtin_amdgcn_fence(__ATOMIC_RELEASE, "agent");
            asm volatile("s_waitcnt vmcnt(0)" ::: "memory");
            const unsigned og = xb_add(&bar[XB_TOP], 1u);
            const unsigned tg = og / nx;
            if (og + 1u == (tg + 1u) * nx) xb_add(&bar[XB_TOPGEN], 1u);
            else XB_SPIN(xb_ld(&bar[XB_TOPGEN]) == tg, bar);
            __builtin_amdgcn_fence(__ATOMIC_ACQUIRE, "agent");
            xb_add(&bar[XB_XGEN(b.x)], 1u);
            asm volatile("s_waitcnt vmcnt(0)" ::: "memory");
        } else {
            XB_SPIN(xb_ld(&bar[XB_XGEN(b.x)]) == gen, bar);
            __builtin_amdgcn_fence(__ATOMIC_ACQUIRE, "agent");
            asm volatile("s_waitcnt vmcnt(0)" ::: "memory");
        }
    }
    __syncthreads();
}

__device__ __forceinline__ unsigned f2bf(float f) { unsigned u = __builtin_bit_cast(unsigned, f); return (u + 0x7fffu + ((u >> 16) & 1u)) >> 16; }
__device__ __forceinline__ unsigned pk2(float lo, float hi) { return f2bf(lo) | (f2bf(hi) << 16); }
__device__ __forceinline__ float bflo(unsigned w) { return __builtin_bit_cast(float, w << 16); }
__device__ __forceinline__ float bfhi(unsigned w) { return __builtin_bit_cast(float, w & 0xffff0000u); }
__device__ __forceinline__ float wave_sum(float v) {
#pragma unroll
    for (int o = 1; o < 64; o <<= 1) v += __shfl_xor(v, o);
    return v;
}
__device__ __forceinline__ float sigmoidf_fast(float x) { return __builtin_amdgcn_rcpf(1.0f + __builtin_amdgcn_exp2f(-1.44269504089f * x)); }

struct Frame {
    LAS unsigned char* lds;
    volatile LAS unsigned* MISC;
    gu32* ctl;
    int tid, lane, wave;
    int vcu, G;
    const float* in[21];
    float* out; unsigned char* ws;
};
enum { I_XP = 0, I_XS, I_CP, I_CS, I_GMIX, I_GMLP, I_WMOD, I_BMOD, I_WIN, I_WF, I_CONVW, I_CONVB, I_WRG, I_BRG, I_WIG, I_BIG, I_LAM, I_WOUT, I_WFF1, I_WFF2, I_GFIN };

__device__ __forceinline__ void p0_transpose_item(const float* W, int ldn, int nsub, bf16* WT, int ldd, int koff, int row_off, LAS float* scr, int item, int lane) {
    const int nblk = nsub / 64, kb = item / nblk, nb = item % nblk, k0 = 64 * kb, n0 = 64 * nb;
    const int r4 = lane >> 4, cq = lane & 15;
    f32x4 v[16];
#pragma unroll
    for (int i = 0; i < 16; ++i) v[i] = *(const GAS f32x4*)(W + (size_t)(k0 + 4 * i + r4) * ldn + n0 + 4 * cq);
#pragma unroll
    for (int i = 0; i < 16; ++i) { LAS float* d = scr + (4 * i + r4) * 65 + 4 * cq; d[0] = v[i][0]; d[1] = v[i][1]; d[2] = v[i][2]; d[3] = v[i][3]; }
    LDS_WAIT(); asm volatile("" ::: "memory");
    const int c = lane & 7;
#pragma unroll
    for (int j = 0; j < 8; ++j) { const int n = (lane >> 3) + 8 * j; const LAS float* s = scr + (8 * c) * 65 + n;
        v4u o; o.x = pk2(s[0 * 65], s[1 * 65]); o.y = pk2(s[2 * 65], s[3 * 65]); o.z = pk2(s[4 * 65], s[5 * 65]); o.w = pk2(s[6 * 65], s[7 * 65]);
        *(GAS v4u*)(WT + (size_t)(row_off + n0 + n) * ldd + koff + k0 + 8 * c) = o; }
    LDS_WAIT(); asm volatile("" ::: "memory");
}
__device__ __forceinline__ void gemv6_wave(const float* W, size_t ldn, const LAS float* vec, int kbase, int lane, f32x4 (&acc)[6]) {
    const int ksub = lane >> 4, cq = lane & 15;
#pragma unroll
    for (int b = 0; b < 6; ++b) acc[b] = (f32x4){0.f, 0.f, 0.f, 0.f};
    const float* wp = W + (size_t)(kbase + ksub) * ldn + 4 * cq;
#pragma unroll 8
    for (int i = 0; i < 32; ++i) { const f32x4 w = *(const GAS f32x4*)(wp + (size_t)(4 * i) * ldn);
#pragma unroll
        for (int b = 0; b < 6; ++b) acc[b] += w * vec[b * 1024 + kbase + 4 * i + ksub]; }
#pragma unroll
    for (int b = 0; b < 6; ++b)
#pragma unroll
        for (int j = 0; j < 4; ++j) { float s = acc[b][j]; s += __shfl_xor(s, 16); s += __shfl_xor(s, 32); acc[b][j] = s; }
}
__device__ __forceinline__ void p0a(Frame& F) {
    const int tid = F.tid, lane = F.lane, wave = F.wave;
    {
        LAS float* sc = (LAS float*)(F.lds);
        LAS float* red = sc + 6144;
        for (int i = tid; i < 6144; i += NWAVES * 64) { const int b = i >> 10, k = i & 1023; const float v = b < 2 ? F.in[I_CP][b * 1024 + k] : F.in[I_CS][(b - 2) * 1024 + k]; sc[i] = v * sigmoidf_fast(v); }
        __syncthreads();
        float* MOD = (float*)(F.ws + WS_MOD);
        for (int item = F.vcu; item < 192; item += F.G) {
            const int l = item / 96, n0 = (item % 96) * 64;
            f32x4 acc[6];
            gemv6_wave(F.in[I_WMOD] + (size_t)l * 1024 * 6144 + n0, 6144, sc, wave * 128, lane, acc);
            if (lane < 16) {
#pragma unroll
                for (int b = 0; b < 6; ++b) *(LAS f32x4*)(red + (wave * 6 + b) * 64 + 4 * lane) = acc[b]; }
            __syncthreads();
            if (tid < 384) { const int b = tid >> 6, ln = tid & 63; float s = 0.f;
#pragma unroll
                for (int w = 0; w < 8; ++w) s += red[(w * 6 + b) * 64 + ln];
                MOD[((size_t)l * 6 + b) * 6144 + n0 + ln] = s + F.in[I_BMOD][l * 6144 + n0 + ln]; }
            __syncthreads();
        }
    }
    {
        LAS float* scr = (LAS float*)(F.lds + wave * 16640);
        const int gw = F.vcu * NWAVES + wave, NGW = F.G * NWAVES;
        constexpr int I_IN = 16 * 24, I_OUT = 8 * 16, I_F1 = 16 * 64, I_F2 = 64 * 16, PER_L = I_IN + I_OUT + I_F1 + I_F2;
        for (int it = gw; it < 2 * PER_L; it += NGW) {
            const int l = it / PER_L; int r = it % PER_L;
            if (r < I_IN) { p0_transpose_item(F.in[I_WIN] + (size_t)l * 1024 * 1536, 1536, 1536, (bf16*)(F.ws + WS_WIN) + (size_t)l * 1536 * 1024, 1024, 0, 0, scr, r, lane); continue; } r -= I_IN;
            if (r < I_OUT) { p0_transpose_item(F.in[I_WOUT] + (size_t)l * 1024 * 1024 + (size_t)512 * 1024, 1024, 1024, (bf16*)(F.ws + WS_WEFF) + (size_t)l * 1024 * 1536, 1536, 1024, 0, scr, r, lane); continue; } r -= I_OUT;
            if (r < I_F1) { p0_transpose_item(F.in[I_WFF1] + (size_t)l * 1024 * 4096, 4096, 4096, (bf16*)(F.ws + WS_WFF1) + (size_t)l * 4096 * 1024, 1024, 0, 0, scr, r, lane); continue; } r -= I_F1;
            p0_transpose_item(F.in[I_WFF2] + (size_t)l * 4096 * 1024, 1024, 1024, (bf16*)(F.ws + WS_WFF2) + (size_t)l * 1024 * 4096, 4096, 0, 0, scr, r, lane);
        }
    }
    {
        const int gt = F.vcu * (NWAVES * 64) + tid, GT = F.G * NWAVES * 64;
        bf16* T1 = (bf16*)(F.ws + WS_T1);
        for (int i = gt; i < 128 * 64; i += GT) { const int row = i >> 6, s1 = i & 63, k1 = row & 63, m = (k1 * s1) & 63; const float x = (float)m * (1.0f / 32.0f);
            T1[i] = (bf16)f2bf(row < 64 ? cospif(x) : -sinpif(x)); }
        bf16* T2 = (bf16*)(F.ws + WS_T2);
        for (int i = gt; i < 128 * 128; i += GT) { const int k2 = i >> 7, s2 = i & 127, m = (k2 * s2) & 127; const float x = (float)m * (1.0f / 64.0f);
            T2[i] = (bf16)f2bf(cospif(x)); T2[128 * 128 + i] = (bf16)f2bf(sinpif(x)); }
        f32x2* TW = (f32x2*)(F.ws + WS_TW);
        for (int i = gt; i < 128 * 64; i += GT) { const int s2 = i >> 6, k1 = i & 63, m = k1 * s2; const float x = (float)m * (1.0f / 4096.0f), sc = 0.011048543456039806f;
            TW[i] = (f32x2){cospif(x) * sc, sinpif(x) * sc}; }
        for (int i = gt; i < 64 * 64; i += GT) { const int s2 = i >> 6, k1 = i & 63, m = k1 * s2; const float x = (float)m * (1.0f / 2048.0f), sc = 0.015625f;
            TW[128 * 64 + i] = (f32x2){cospif(x) * sc, sinpif(x) * sc}; }
        float* CSW = (float*)(F.ws + WS_CSW);
        for (int i = gt; i < 2 * 8 * 2 * 4096; i += GT) { const int e = i & 63, d = (i >> 6) & 63, ty = (i >> 12) & 1, lh = i >> 13;
            const float* wf = F.in[I_WF] + (size_t)lh * 4096 + e; float s = 0.f;
            for (int m = 0; m < 64; ++m) { const float x = (float)((m * d) & 63) * (1.0f / 32.0f); s += (ty ? -sinpif(x) : cospif(x)) * wf[m * 64]; }
            CSW[i] = s * 0.125f; }
        bf16* WG = (bf16*)(F.ws + WS_WG);
        for (int i = gt; i < 2 * 8 * 320 * 64; i += GT) { const int k = i & 63, n = (i >> 6) % 320, lh = (i >> 6) / 320, l = lh >> 3, h = lh & 7; float v;
            if (n < 256) { const int g = n >> 6, e = n & 63, dir = g >> 1; const float* src = (g & 1) ? F.in[I_WIG] : F.in[I_WRG]; v = -1.44269504089f * src[((size_t)((l * 2 + dir) * 8 + h) * 64 + k) * 64 + e]; }
            else v = (k == n - 256) ? 1.0f : 0.0f;
            WG[i] = (bf16)f2bf(v); }
        float* CL = (float*)(F.ws + WS_CL);
        for (int i = gt; i < 2 * 2 * 512; i += GT) { const float lam = F.in[I_LAM][i]; CL[i] = -8.0f * log1pf(expf(-lam)) * 1.44269504089f; }
    }
}

__device__ __forceinline__ void p0b(Frame& F) {
    const int tid = F.tid, lane = F.lane, wave = F.wave;
    const float* MOD = (const float*)(F.ws + WS_MOD);
    {
        LAS float* sh = (LAS float*)(F.lds + 65536);
        LAS float* red = sh + 6144;
        for (int item = F.vcu; item < 176; item += F.G) {
            const int l = item / 88, r = item % 88; const bool is1 = r < 24; const int n0 = (is1 ? r : r - 24) * 64, ldn = is1 ? 1536 : 4096, kind = is1 ? 0 : 3;
            __syncthreads();
            for (int i = tid; i < 6144; i += NWAVES * 64) { const int b = i >> 10, k = i & 1023; sh[i] = MOD[((size_t)l * 6 + b) * 6144 + kind * 1024 + k]; }
            __syncthreads();
            f32x4 acc[6];
            gemv6_wave((is1 ? F.in[I_WIN] + (size_t)l * 1024 * 1536 : F.in[I_WFF1] + (size_t)l * 1024 * 4096) + n0, ldn, sh, wave * 128, lane, acc);
            if (lane < 16) {
#pragma unroll
                for (int b = 0; b < 6; ++b) *(LAS f32x4*)(red + (wave * 6 + b) * 64 + 4 * lane) = acc[b]; }
            __syncthreads();
            if (tid < 384) { const int b = tid >> 6, ln = tid & 63; float s = 0.f;
#pragma unroll
                for (int w = 0; w < 8; ++w) s += red[(w * 6 + b) * 64 + ln];
                float* dst = is1 ? (float*)(F.ws + WS_BIAS1) + ((size_t)l * 6 + b) * 1536 : (float*)(F.ws + WS_BIAS2) + ((size_t)l * 6 + b) * 4096;
                dst[n0 + ln] = s; }
        }
        __syncthreads();
    }
    {
        LAS float* wo = (LAS float*)(F.lds);
        LAS float* cw = wo + 4096;
        LAS float* sw = cw + 4096;
        const float* CSW = (const float*)(F.ws + WS_CSW);
        for (int item = F.vcu; item < 256; item += F.G) {
            const int nb = item & 15, h = (item >> 4) & 7, l = item >> 7;
            __syncthreads();
            for (int i = tid; i < 4096; i += NWAVES * 64) { const int e = i >> 6, n = i & 63;
                wo[i] = F.in[I_WOUT][(size_t)l * 1024 * 1024 + (size_t)(h * 64 + e) * 1024 + nb * 64 + n];
                cw[i] = CSW[((size_t)(l * 8 + h) * 2 + 0) * 4096 + i]; sw[i] = CSW[((size_t)(l * 8 + h) * 2 + 1) * 4096 + i]; }
            __syncthreads();
            const int n = tid & 63, d0 = (tid >> 6) * 8;
            float aw[8], bw[8];
#pragma unroll
            for (int j = 0; j < 8; ++j) { aw[j] = 0.f; bw[j] = 0.f; }
            for (int e = 0; e < 64; ++e) { const float w = wo[e * 64 + n];
#pragma unroll
                for (int j = 0; j < 8; ++j) { aw[j] += cw[(d0 + j) * 64 + e] * w; bw[j] += sw[(d0 + j) * 64 + e] * w; } }
            bf16* dst = (bf16*)(F.ws + WS_WEFF) + (size_t)l * 1024 * 1536 + (size_t)(nb * 64 + n) * 1536 + h * 64 + d0;
            v4u oa, ob; oa.x = pk2(aw[0], aw[1]); oa.y = pk2(aw[2], aw[3]); oa.z = pk2(aw[4], aw[5]); oa.w = pk2(aw[6], aw[7]);
            ob.x = pk2(bw[0], bw[1]); ob.y = pk2(bw[2], bw[3]); ob.z = pk2(bw[4], bw[5]); ob.w = pk2(bw[6], bw[7]);
            *(GAS v4u*)(dst) = oa; *(GAS v4u*)(dst + 512) = ob;
        }
        __syncthreads();
    }
    {
        const int gt = F.vcu * (NWAVES * 64) + tid, GT = F.G * NWAVES * 64;
        float* VEC = (float*)(F.ws + WS_VEC);
        for (int i = gt; i < 2 * 6 * 4 * 1024; i += GT) { const int k = i & 1023, kind = (i >> 10) & 3, lb = i >> 12, l = lb / 6; const float* m = MOD + (size_t)lb * 6144; float v;
            if (kind == 0) v = F.in[I_GMIX][l * 1024 + k] * (1.0f + m[1024 + k]);
            else if (kind == 1) v = m[2048 + k];
            else if (kind == 2) v = F.in[I_GMLP][l * 1024 + k] * (1.0f + m[4096 + k]);
            else v = m[5120 + k];
            VEC[i] = v; }
    }
    {
        const int gw = F.vcu * NWAVES + wave, NGW = F.G * NWAVES;
        bf16* A = (bf16*)(F.ws + WS_A); float* SS = (float*)(F.ws + WS_SS);
        for (int row0 = gw * 4; row0 < MTOK; row0 += NGW * 4) {
            const int b = pg8::seq_of_row(row0);
            const float* sc1 = MOD + (size_t)b * 6144 + 1024;
            f32x4 v[4][4];
#pragma unroll
            for (int rr = 0; rr < 4; ++rr) { const int row = row0 + rr; const float* xr = row < 16384 ? F.in[I_XP] + (size_t)row * 1024 : F.in[I_XS] + (size_t)(row - 16384) * 1024;
#pragma unroll
                for (int j = 0; j < 4; ++j) v[rr][j] = *(const GAS f32x4*)(xr + 4 * lane + 256 * j); }
            f32x4 al[4];
#pragma unroll
            for (int j = 0; j < 4; ++j) { const f32x4 g = *(const f32x4*)(F.in[I_GMIX] + 4 * lane + 256 * j), sc = *(const f32x4*)(sc1 + 4 * lane + 256 * j); al[j] = g * (1.0f + sc); }
#pragma unroll
            for (int rr = 0; rr < 4; ++rr) { const int row = row0 + rr; float s = 0.f;
#pragma unroll
                for (int j = 0; j < 4; ++j) s += (v[rr][j][0] * v[rr][j][0] + v[rr][j][1] * v[rr][j][1]) + (v[rr][j][2] * v[rr][j][2] + v[rr][j][3] * v[rr][j][3]);
                s = wave_sum(s);
#pragma unroll
                for (int j = 0; j < 4; ++j) { const f32x4 a = v[rr][j] * al[j];
                    v2u o; o.x = pk2(a[0], a[1]); o.y = pk2(a[2], a[3]);
                    *(GAS v2u*)(A + (size_t)row * 1024 + 4 * lane + 256 * j) = o; }
                if (lane < 16) SS[(size_t)row * 16 + lane] = lane == 0 ? s : 0.f; }
        }
    }
}

__device__ __forceinline__ void final_norm(Frame& F) {
    const int gw = F.vcu * NWAVES + F.wave, NGW = F.G * NWAVES, lane = F.lane;
    const float* SS = (const float*)(F.ws + WS_SS);
    f32x4 g[4];
#pragma unroll
    for (int j = 0; j < 4; ++j) g[j] = *(const f32x4*)(F.in[I_GFIN] + 4 * lane + 256 * j);
    for (int row0 = gw * 4; row0 < MTOK; row0 += NGW * 4) {
        f32x4 v[4][4]; float r[4];
#pragma unroll
        for (int rr = 0; rr < 4; ++rr) { float* xr = F.out + (size_t)(row0 + rr) * 1024; r[rr] = pg8::row_rscale(SS, row0 + rr);
#pragma unroll
            for (int j = 0; j < 4; ++j) v[rr][j] = *(const GAS f32x4*)(xr + 4 * lane + 256 * j); }
#pragma unroll
        for (int rr = 0; rr < 4; ++rr) { float* xr = F.out + (size_t)(row0 + rr) * 1024;
#pragma unroll
            for (int j = 0; j < 4; ++j) *(GAS f32x4*)(xr + 4 * lane + 256 * j) = v[rr][j] * r[rr] * g[j]; }
    }
}
__device__ __forceinline__ void load_wg_tables(Frame& F, int l, int h) {
    const bf16* WG = (const bf16*)(F.ws + WS_WG) + (size_t)(l * 8 + h) * 320 * 64;
    for (int i = F.tid; i < 320 * 8; i += NWAVES * 64) { const int n = i >> 3, c = i & 7; *(LAS v4u*)(F.lds + L_WG + n * 144 + c * 16) = *(const GAS v4u*)(WG + n * 64 + c * 8); }
    LAS float* par = (LAS float*)(F.lds + L_PAR);
    for (int i = F.tid; i < 11 * 64; i += NWAVES * 64) { const int p = i >> 6, c = i & 63, ch = h * 64 + c; float v;
        if (p < 4) v = F.in[I_CONVW][(size_t)l * 4 * 512 + p * 512 + ch];
        else if (p == 4) v = F.in[I_CONVB][l * 512 + ch];
        else if (p == 5) v = -1.44269504089f * F.in[I_BRG][(l * 2 + 0) * 512 + ch];
        else if (p == 6) v = -1.44269504089f * F.in[I_BIG][(l * 2 + 0) * 512 + ch];
        else if (p == 7) v = -1.44269504089f * F.in[I_BRG][(l * 2 + 1) * 512 + ch];
        else if (p == 8) v = -1.44269504089f * F.in[I_BIG][(l * 2 + 1) * 512 + ch];
        else if (p == 9) v = ((const float*)(F.ws + WS_CL))[(l * 2 + 0) * 512 + ch];
        else v = ((const float*)(F.ws + WS_CL))[(l * 2 + 1) * 512 + ch];
        par[i] = v; }
}
__device__ __forceinline__ void load_t1(Frame& F) {
    const bf16* T1 = (const bf16*)(F.ws + WS_T1);
    for (int i = F.tid; i < 128 * 8; i += NWAVES * 64) { const int r = i >> 3, c = i & 7; *(LAS v4u*)(F.lds + L_T1 + r * 144 + c * 16) = *(const GAS v4u*)(T1 + r * 64 + c * 8); }
}
__device__ __forceinline__ void load_t2(Frame& F) {
    const bf16* T2 = (const bf16*)(F.ws + WS_T2);
    for (int i = F.tid; i < 2 * 128 * 16; i += NWAVES * 64) { const int t = i >> 11, r = (i >> 4) & 127, c = i & 15; *(LAS v4u*)(F.lds + (t ? L_T2S : L_T2) + r * 272 + c * 16) = *(const GAS v4u*)(T2 + (size_t)t * 16384 + r * 128 + c * 8); }
}

__device__ __forceinline__ f32x2 exp2_2(f32x2 v) { f32x2 r; r.x = __builtin_amdgcn_exp2f(v.x); r.y = __builtin_amdgcn_exp2f(v.y); return r; }
__device__ __forceinline__ f32x2 rcp_2(f32x2 v) { f32x2 r; r.x = __builtin_amdgcn_rcpf(v.x); r.y = __builtin_amdgcn_rcpf(v.y); return r; }
__device__ __forceinline__ f32x2 sqrt_2(f32x2 v) { f32x2 r; r.x = __builtin_amdgcn_sqrtf(v.x); r.y = __builtin_amdgcn_sqrtf(v.y); return r; }
template <bool FINAL>
__device__ __forceinline__ void lru_unit(Frame& F, int b, int h, int jseq, int jslot) {
    int lane = F.lane; asm volatile("" : "+v"(lane));
    const int w = F.wave, q = lane & 31, hh = lane >> 5;
    const int tokS = seq_tok0(b), S = seq_len(b);
    const int tw0 = tokS + 256 * jseq + 32 * w;
    const LAS unsigned char* Wg = F.lds + L_WG; const LAS float* par = (const LAS float*)(F.lds + L_PAR);
    LAS float* agg = (LAS float*)(F.lds + L_AGG); const LAS float* cu = (const LAS float*)(F.lds + L_CU);
    const bf16* Z = (const bf16*)(F.ws + WS_Z);
    bf16x8 Af[4], Ag[4];
    {
        const int t = tw0 + q;
        const bf16* zr = Z + (size_t)t * DIN + 512 + h * 64;
        if (FINAL) {
#pragma unroll
            for (int ks = 0; ks < 4; ++ks) Ag[ks] = __builtin_bit_cast(bf16x8, *(const GAS v4u*)(zr + 512 + 16 * ks + 8 * hh));
        }
#pragma unroll
        for (int ks = 0; ks < 4; ++ks) {
            const int c0 = 16 * ks + 8 * hh;
            f32x2 a8[4];
            { const f32x4 b0 = *(const LAS f32x4*)(par + 4 * 64 + c0), b1 = *(const LAS f32x4*)(par + 4 * 64 + c0 + 4);
              a8[0] = (f32x2){b0[0], b0[1]}; a8[1] = (f32x2){b0[2], b0[3]}; a8[2] = (f32x2){b1[0], b1[1]}; a8[3] = (f32x2){b1[2], b1[3]}; }
#pragma unroll
            for (int kk = 0; kk < 4; ++kk) {
                const int tt = t - 2 + kk; const bool valid = (tt >= tokS) && (tt < tokS + S);
                v4u raw = (v4u){0u, 0u, 0u, 0u};
                if (valid) raw = *(const GAS v4u*)(zr + (ptrdiff_t)(kk - 2) * DIN + c0);
                const f32x4 w0 = *(const LAS f32x4*)(par + kk * 64 + c0), w1 = *(const LAS f32x4*)(par + kk * 64 + c0 + 4);
                a8[0] += (f32x2){bflo(raw.x), bfhi(raw.x)} * (f32x2){w0[0], w0[1]}; a8[1] += (f32x2){bflo(raw.y), bfhi(raw.y)} * (f32x2){w0[2], w0[3]};
                a8[2] += (f32x2){bflo(raw.z), bfhi(raw.z)} * (f32x2){w1[0], w1[1]}; a8[3] += (f32x2){bflo(raw.w), bfhi(raw.w)} * (f32x2){w1[2], w1[3]};
            }
            v4u pk; pk.x = pk2(a8[0].x, a8[0].y); pk.y = pk2(a8[1].x, a8[1].y); pk.z = pk2(a8[2].x, a8[2].y); pk.w = pk2(a8[3].x, a8[3].y);
            Af[ks] = __builtin_bit_cast(bf16x8, pk);
        }
    }
#pragma unroll 1
    for (int e2 = 0; e2 < 2; ++e2) {
        f32x16 acc[5], aug;
#pragma unroll
        for (int g = 0; g < 5; ++g)
#pragma unroll
            for (int i = 0; i < 16; ++i) acc[g][i] = 0.f;
#pragma unroll
        for (int i = 0; i < 16; ++i) aug[i] = 0.f;
#pragma unroll
        for (int ks = 0; ks < 4; ++ks)
#pragma unroll
            for (int g = 0; g < 5; ++g) { const int n = (g < 4 ? g * 64 : 256) + e2 * 32 + q;
                const bf16x8 Bf = *(const LAS bf16x8*)(Wg + n * 144 + (16 * ks + 8 * hh) * 2);
                acc[g] = __builtin_amdgcn_mfma_f32_32x32x16_bf16(Af[ks], Bf, acc[g], 0, 0, 0);
                if (FINAL && g == 4) aug = __builtin_amdgcn_mfma_f32_32x32x16_bf16(Ag[ks], Bf, aug, 0, 0, 0); }
        const int c = e2 * 32 + q;
        const float brf = par[5 * 64 + c], bif = par[6 * 64 + c], brb = par[7 * 64 + c], bib = par[8 * 64 + c], clf = par[9 * 64 + c], clb = par[10 * 64 + c];
#pragma unroll
        for (int i = 0; i < 16; i += 2) {
            const f32x2 uc = (f32x2){acc[4][i], acc[4][i + 1]};
            const f32x2 rf = rcp_2(exp2_2((f32x2){acc[0][i], acc[0][i + 1]} + brf) + 1.0f), gi = rcp_2(exp2_2((f32x2){acc[1][i], acc[1][i + 1]} + bif) + 1.0f);
            const f32x2 af = exp2_2(rf * clf);
            const f32x2 bxf = sqrt_2(1.0f - af * af) * (gi * uc);
            acc[0][i] = af.x; acc[0][i + 1] = af.y; acc[1][i] = bxf.x; acc[1][i + 1] = bxf.y;
            const f32x2 rb = rcp_2(exp2_2((f32x2){acc[2][i], acc[2][i + 1]} + brb) + 1.0f), gib = rcp_2(exp2_2((f32x2){acc[3][i], acc[3][i + 1]} + bib) + 1.0f);
            const f32x2 ab = exp2_2(rb * clb);
            const f32x2 bxb = sqrt_2(1.0f - ab * ab) * (gib * uc);
            acc[2][i] = ab.x; acc[2][i + 1] = ab.y; acc[3][i] = bxb.x; acc[3][i + 1] = bxb.y;
        }
        float Pg[4], Hg[4], oP[4], oH[4];
#pragma unroll
        for (int g = 0; g < 4; ++g) { float hs = 0.f, p = 1.f;
#pragma unroll
            for (int r = 0; r < 4; ++r) { const int i = 4 * g + r; hs = acc[0][i] * hs + acc[1][i]; p *= acc[0][i]; acc[1][i] = hs; acc[0][i] = p; }
            Pg[g] = p; Hg[g] = hs; oP[g] = __shfl_xor(p, 32); oH[g] = __shfl_xor(hs, 32); }
        float cg0f[4], ppf[4], Pwf, Hwf;
        { float cc = 0.f, pp = 1.f;
#pragma unroll
            for (int g = 0; g < 4; ++g) { const float Pl = hh ? oP[g] : Pg[g], Hl = hh ? oH[g] : Hg[g], Ph = hh ? Pg[g] : oP[g], Hh = hh ? Hg[g] : oH[g];
                const float c_lo = cc, p_lo = pp; cc = Pl * cc + Hl; pp *= Pl;
                const float c_hi = cc, p_hi = pp; cc = Ph * cc + Hh; pp *= Ph;
                cg0f[g] = hh ? c_hi : c_lo; ppf[g] = hh ? p_hi : p_lo; }
            Pwf = pp; Hwf = cc; }
#pragma unroll
        for (int g = 0; g < 4; ++g) { float hs = 0.f, p = 1.f;
#pragma unroll
            for (int r = 3; r >= 0; --r) { const int i = 4 * g + r; hs = acc[2][i] * hs + acc[3][i]; p *= acc[2][i]; acc[3][i] = hs; acc[2][i] = p; }
            Pg[g] = p; Hg[g] = hs; oP[g] = __shfl_xor(p, 32); oH[g] = __shfl_xor(hs, 32); }
        float cg0b[4], ppb[4], Pwb, Hwb;
        { float cc = 0.f, pp = 1.f;
#pragma unroll
            for (int g = 3; g >= 0; --g) { const float Pl = hh ? oP[g] : Pg[g], Hl = hh ? oH[g] : Hg[g], Ph = hh ? Pg[g] : oP[g], Hh = hh ? Hg[g] : oH[g];
                const float c_hi = cc, p_hi = pp; cc = Ph * cc + Hh; pp *= Ph;
                const float c_lo = cc, p_lo = pp; cc = Pl * cc + Hl; pp *= Pl;
                cg0b[g] = hh ? c_hi : c_lo; ppb[g] = hh ? p_hi : p_lo; }
            Pwb = pp; Hwb = cc; }
        if (hh == 0) { *(LAS f32x2*)(agg + (((e2 * 8 + w) * 2 + 0) * 32 + q) * 2) = (f32x2){Pwf, Hwf}; *(LAS f32x2*)(agg + (((e2 * 8 + w) * 2 + 1) * 32 + q) * 2) = (f32x2){Pwb, Hwb}; }
        if (FINAL) {
            __syncthreads();
            float cf = cu[(jslot * 2 + 0) * 64 + c], cb = cu[(jslot * 2 + 1) * 64 + c];
            for (int ww = 0; ww < w; ++ww) { const f32x2 a = *(const LAS f32x2*)(agg + (((e2 * 8 + ww) * 2 + 0) * 32 + q) * 2); cf = a.x * cf + a.y; }
            for (int ww = 7; ww > w; --ww) { const f32x2 a = *(const LAS f32x2*)(agg + (((e2 * 8 + ww) * 2 + 1) * 32 + q) * 2); cb = a.x * cb + a.y; }
            LAS bf16* yt = (LAS bf16*)(F.lds + L_YT + w * 4608) + c;
#pragma unroll
            for (int g = 0; g < 4; ++g) {
                const float carf = cg0f[g] + ppf[g] * cf, carb = cg0b[g] + ppb[g] * cb;
#pragma unroll
                for (int r = 0; r < 4; r += 2) { const int i = 4 * g + r, tok = r + 8 * g + 4 * hh;
                    const f32x2 hf = (f32x2){acc[1][i], acc[1][i + 1]} + (f32x2){acc[0][i], acc[0][i + 1]} * carf, hb = (f32x2){acc[3][i], acc[3][i + 1]} + (f32x2){acc[2][i], acc[2][i + 1]} * carb;
                    const f32x2 x = (f32x2){aug[i], aug[i + 1]};
                    const f32x2 y2 = (x + (x * x) * x * 0.044715f) * (-2.3022081981f);
                    const f32x2 ge = x * rcp_2(exp2_2(y2) + 1.0f);
                    const f32x2 y = (hf + hb) * ge;
                    yt[tok * 72] = (bf16)f2bf(y.x); yt[(tok + 1) * 72] = (bf16)f2bf(y.y); }
            }
        }
    }
    if (FINAL) {
        LDS_WAIT(); asm volatile("" ::: "memory");
        const LAS unsigned char* yr = F.lds + L_YT + w * 4608 + q * 144 + hh * 64;
        bf16* yo = (bf16*)(F.ws + WS_A2) + (size_t)(tw0 + q) * DIN + 1024 + h * 64 + hh * 32;
#pragma unroll
        for (int j = 0; j < 4; ++j) *(GAS v4u*)(yo + 8 * j) = *(const LAS v4u*)(yr + 16 * j);
    }
    if (!FINAL) {
        __syncthreads();
        if (F.tid < 128) { const int dir = F.tid >> 6, c = F.tid & 63, e2 = c >> 5, qq = c & 31; float P = 1.f, H = 0.f;
            if (dir == 0) { for (int ww = 0; ww < 8; ++ww) { const f32x2 a = *(const LAS f32x2*)(agg + (((e2 * 8 + ww) * 2 + 0) * 32 + qq) * 2); H = a.x * H + a.y; P *= a.x; } }
            else { for (int ww = 7; ww >= 0; --ww) { const f32x2 a = *(const LAS f32x2*)(agg + (((e2 * 8 + ww) * 2 + 1) * 32 + qq) * 2); H = a.x * H + a.y; P *= a.x; } }
            float* AGG = (float*)(F.ws + WS_AGG);
            *(f32x2*)(AGG + ((((size_t)(b * 8 + h) * 32 + jseq) * 2 + dir) * 64 + c) * 2) = (f32x2){P, H}; }
    }
    __syncthreads();
}
template <bool FINAL>
__device__ __forceinline__ void lru_phase(Frame& F, int l) {
#pragma unroll 1
    for (int v = F.vcu; v < 256; v += F.G) {
        const int h = v >> 5, rg = v & 31, tok = rg * 1024, b = pg8::seq_of_row(tok), j0 = (tok - seq_tok0(b)) >> 8, nch = seq_len(b) >> 8;
        { int t_ = F.tid; asm volatile("" : "+v"(t_)); F.tid = t_; F.lane = t_ & 63; }
        __syncthreads();
        load_wg_tables(F, l, h);
        if (FINAL) {
            const float* AGG = (const float*)(F.ws + WS_AGG) + (size_t)(b * 8 + h) * 32 * 256;
            for (int i = F.tid; i < nch * 64; i += NWAVES * 64) *(LAS v4u*)(F.lds + L_STREAM + i * 16) = *(const GAS v4u*)(AGG + i * 4);
            __syncthreads();
            if (F.tid < 128) { const int dir = F.tid >> 6, c = F.tid & 63; LAS float* cu = (LAS float*)(F.lds + L_CU); const LAS float* st = (const LAS float*)(F.lds + L_STREAM);
                float cc = 0.f;
                if (dir == 0) { for (int j = 0; j < j0 + 4; ++j) { if (j >= j0) cu[((j - j0) * 2 + 0) * 64 + c] = cc; const f32x2 a = *(const LAS f32x2*)(st + ((j * 2 + 0) * 64 + c) * 2); cc = a.x * cc + a.y; } }
                else { for (int j = nch - 1; j >= j0; --j) { if (j < j0 + 4) cu[((j - j0) * 2 + 1) * 64 + c] = cc; const f32x2 a = *(const LAS f32x2*)(st + ((j * 2 + 1) * 64 + c) * 2); cc = a.x * cc + a.y; } }
            }
        }
        __syncthreads();
#pragma unroll 1
        for (int jj = 0; jj < 4; ++jj) lru_unit<FINAL>(F, b, h, j0 + jj, jj);
    }
}

__device__ __forceinline__ unsigned perm_lo(unsigned a, unsigned b) { return __builtin_amdgcn_perm(b, a, 0x05040100u); }
__device__ __forceinline__ unsigned perm_hi(unsigned a, unsigned b) { return __builtin_amdgcn_perm(b, a, 0x07060302u); }
__device__ __forceinline__ void make_bfrags(const v2u (&X)[8], bf16x8 (&Bf)[4]) {
#pragma unroll
    for (int jp = 0; jp < 4; ++jp) { v4u o;
        const unsigned a0 = (jp >> 1) ? X[0].y : X[0].x, a1 = (jp >> 1) ? X[1].y : X[1].x, a2 = (jp >> 1) ? X[2].y : X[2].x, a3 = (jp >> 1) ? X[3].y : X[3].x;
        const unsigned a4 = (jp >> 1) ? X[4].y : X[4].x, a5 = (jp >> 1) ? X[5].y : X[5].x, a6 = (jp >> 1) ? X[6].y : X[6].x, a7 = (jp >> 1) ? X[7].y : X[7].x;
        if (jp & 1) { o.x = perm_hi(a0, a1); o.y = perm_hi(a2, a3); o.z = perm_hi(a4, a5); o.w = perm_hi(a6, a7); }
        else { o.x = perm_lo(a0, a1); o.y = perm_lo(a2, a3); o.z = perm_lo(a4, a5); o.w = perm_lo(a6, a7); }
        Bf[jp] = __builtin_bit_cast(bf16x8, o); }
}
__device__ __forceinline__ void dft1_unit(Frame& F, int b, int s2, int cg) {
    int lane = F.lane; asm volatile("" : "+v"(lane));
    const int q = lane & 15, g = lane >> 4;
    const int tokS = seq_tok0(b), N2 = seq_len(b) >> 6;
    const bf16* Z = (const bf16*)(F.ws + WS_Z) + (size_t)(tokS + s2) * DIN + cg * 64 + 4 * q;
    pg8::f32x4 acc[8][4];
#pragma unroll
    for (int mt = 0; mt < 8; ++mt)
#pragma unroll
        for (int jp = 0; jp < 4; ++jp) acc[mt][jp] = (pg8::f32x4){0.f, 0.f, 0.f, 0.f};
#pragma unroll
    for (int ks = 0; ks < 2; ++ks) {
        v2u X[8];
#pragma unroll
        for (int i = 0; i < 8; ++i) X[i] = *(const GAS v2u*)(Z + (size_t)(32 * ks + 8 * g + i) * N2 * DIN);
        bf16x8 Bf[4]; make_bfrags(X, Bf);
#pragma unroll
        for (int mt = 0; mt < 8; ++mt) { const bf16x8 Afr = *(const LAS bf16x8*)(F.lds + L_T1 + (16 * mt + q) * 144 + (32 * ks + 8 * g) * 2);
#pragma unroll
            for (int jp = 0; jp < 4; ++jp) acc[mt][jp] = __builtin_amdgcn_mfma_f32_16x16x32_bf16(Afr, Bf[jp], acc[mt][jp], 0, 0, 0); }
    }
    const f32x2* TW = (const f32x2*)(F.ws + WS_TW) + (N2 == 128 ? 0 : 128 * 64) + (size_t)s2 * 64;
    bf16* Hb = (bf16*)(F.ws + WS_H) + (size_t)tokS * 1024 + cg * 64 + 4 * q;
#pragma unroll
    for (int mt = 0; mt < 4; ++mt)
#pragma unroll
        for (int r = 0; r < 4; ++r) { const int k1 = 16 * mt + 4 * g + r; const f32x2 t = TW[k1];
            float hr[4], hi[4];
#pragma unroll
            for (int jp = 0; jp < 4; ++jp) { const float a = acc[mt][jp][r], bb = acc[mt + 4][jp][r]; hr[jp] = a * t.x + bb * t.y; hi[jp] = bb * t.x - a * t.y; }
            v2u o; o.x = pk2(hr[0], hr[1]); o.y = pk2(hr[2], hr[3]);
            *(GAS v2u*)(Hb + ((size_t)(k1 * 2 + 0) * N2 + s2) * 512) = o;
            o.x = pk2(hi[0], hi[1]); o.y = pk2(hi[2], hi[3]);
            *(GAS v2u*)(Hb + ((size_t)(k1 * 2 + 1) * N2 + s2) * 512) = o; }
}
__device__ __forceinline__ void dft1_phase(Frame& F) {
    const int gw = F.vcu * NWAVES + F.wave, NGW = F.G * NWAVES;
#pragma unroll 1
    for (int id = gw; id < 4096; id += NGW) {
        int b, s2, cg;
        if (id < 2048) { b = id >> 10; const int rem = id & 1023; s2 = rem >> 3; cg = rem & 7; }
        else { const int i2 = id - 2048; b = 2 + (i2 >> 9); const int rem = i2 & 511; s2 = rem >> 3; cg = rem & 7; }
        dft1_unit(F, b, s2, cg);
    }
}
__device__ __forceinline__ void dft2_unit(Frame& F, int b, int k1, int cg, int mh) {
    int lane = F.lane; asm volatile("" : "+v"(lane));
    const int q = lane & 15, g = lane >> 4;
    const int tokS = seq_tok0(b), N2 = seq_len(b) >> 6, rs = 128 / N2;
    const bf16* Hb = (const bf16*)(F.ws + WS_H) + (size_t)tokS * 1024 + (size_t)k1 * 2 * N2 * 512 + cg * 64 + 4 * q;
    pg8::f32x4 acc[8][4];
#pragma unroll
    for (int mt = 0; mt < 8; ++mt)
#pragma unroll
        for (int jp = 0; jp < 4; ++jp) acc[mt][jp] = (pg8::f32x4){0.f, 0.f, 0.f, 0.f};
    const int nks = (2 * N2) >> 5;
#pragma unroll 1
    for (int ks = 0; ks < nks; ++ks) {
        v2u X[8];
#pragma unroll
        for (int i = 0; i < 8; ++i) X[i] = *(const GAS v2u*)(Hb + (size_t)(32 * ks + 8 * g + i) * 512);
        bf16x8 Bf[4]; make_bfrags(X, Bf);
        const int kk0 = 32 * ks + 8 * g, ri = kk0 >= N2 ? 1 : 0, s20 = kk0 - ri * N2;
#pragma unroll
        for (int mt = 0; mt < 8; ++mt) {
            const int R = 128 * mh + 16 * mt + q, ty = R >= N2 ? 1 : 0, k2 = R - ty * N2;
            const bool useC = (ty == ri), neg = (ty == 1) && (ri == 1);
            v4u a = *(const LAS v4u*)(F.lds + (useC ? L_T2 : L_T2S) + (k2 * rs) * 272 + s20 * 2);
            if (neg) { a.x ^= 0x80008000u; a.y ^= 0x80008000u; a.z ^= 0x80008000u; a.w ^= 0x80008000u; }
            const bf16x8 Afr = __builtin_bit_cast(bf16x8, a);
#pragma unroll
            for (int jp = 0; jp < 4; ++jp) acc[mt][jp] = __builtin_amdgcn_mfma_f32_16x16x32_bf16(Afr, Bf[jp], acc[mt][jp], 0, 0, 0); }
    }
    bf16* A2 = (bf16*)(F.ws + WS_A2) + (size_t)tokS * DIN + cg * 64 + 4 * q;
#pragma unroll
    for (int mt = 0; mt < 8; ++mt)
#pragma unroll
        for (int r = 0; r < 4; ++r) { const int R = 128 * mh + 16 * mt + 4 * g + r, ty = R >= N2 ? 1 : 0, k2 = R - ty * N2, k = k1 + 64 * k2;
            v2u o; o.x = pk2(acc[mt][0][r], acc[mt][1][r]); o.y = pk2(acc[mt][2][r], acc[mt][3][r]);
            *(GAS v2u*)(A2 + (size_t)k * DIN + ty * 512) = o; }
}
__device__ __forceinline__ void dft2_phase(Frame& F) {
    const int gw = F.vcu * NWAVES + F.wave, NGW = F.G * NWAVES;
#pragma unroll 1
    for (int id = gw; id < 2048; id += NGW) {
        const int b = id >> 10, rem = id & 1023; dft2_unit(F, b, rem >> 4, (rem >> 1) & 7, rem & 1); }
#pragma unroll 1
    for (int id = gw; id < 2048; id += NGW) {
        const int b = 2 + (id >> 9), rem = id & 511; dft2_unit(F, b, rem >> 3, rem & 7, 0); }
}
struct Args { const float* in[21]; float* out; unsigned char* ws; int ph_lo, ph_hi; };
__global__ void __launch_bounds__(NWAVES * 64, 2) mk_fwd(Args args) {
    extern __shared__ __attribute__((aligned(16))) unsigned char lds[];
    Frame F;
    F.lds = (LAS unsigned char*)lds;
    F.MISC = (volatile LAS unsigned*)(F.lds + MISC_OFF);
    F.tid = threadIdx.x; F.lane = F.tid & 63; F.wave = __builtin_amdgcn_readfirstlane(F.tid >> 6);
    F.G = gridDim.x; { const int bx = blockIdx.x; F.vcu = (F.G % 8 == 0) ? (bx % 8) * (F.G / 8) + bx / 8 : bx; }
#pragma unroll
    for (int i = 0; i < 21; ++i) F.in[i] = args.in[i];
    F.out = args.out; F.ws = args.ws; F.ctl = (gu32*)(args.ws + WS_CTL);
    if (F.tid < 64) ((LAS unsigned*)(F.lds + MISC_OFF))[F.tid] = 0u;
    __syncthreads();
    XcdBarrier bar; bar.bar = (unsigned*)(F.ctl + CW_BAR); bar.x = 0; bar.st = nullptr;
    if (N_LAUNCHES == 1) bar = xcd_barrier_post((unsigned*)(F.ctl + CW_BAR), F.MISC + 8);
    const int lo = args.ph_lo, hi = args.ph_hi;
#define IN(k) (lo <= (k) && (k) < hi)
#ifndef REP_P0
#define REP_P0 1
#endif
#ifndef REP_G1
#define REP_G1 1
#endif
#ifndef REP_M
#define REP_M 1
#endif
#ifndef REP_G3
#define REP_G3 1
#endif
#ifndef REP_LRU
#define REP_LRU 1
#endif
#ifndef REP_DFT
#define REP_DFT 1
#endif
#define SEAM(k) do { if (IN(k) && IN((k) + 1)) xcd_barrier(bar); } while (0)

    #ifndef NO_P0A
    if (IN(0)) { for (int rep_ = 0; rep_ < REP_P0; ++rep_) p0a(F); }
#endif
    SEAM(0);
    #ifndef NO_P0B
    if (IN(1)) { for (int rep_ = 0; rep_ < REP_P0; ++rep_) p0b(F); }
#endif
    SEAM(1);
    float* SS = (float*)(F.ws + WS_SS);
    const float* VEC = (const float*)(F.ws + WS_VEC);
#pragma unroll 1
    for (int l = 0; l < DEPTH; ++l) {
        const int pb = 2 + 6 * l;
#define REFRESH() do { int t_ = F.tid; asm volatile("" : "+v"(t_)); F.tid = t_; F.lane = t_ & 63; F.wave = __builtin_amdgcn_readfirstlane(t_ >> 6); } while (0)
#ifndef NO_G1
        if (IN(pb + 0)) for (int rep_ = 0; rep_ < REP_G1; ++rep_) { REFRESH();
            pg8::Gemm g{(const pg8::bf16_t*)(F.ws + WS_A), (const pg8::bf16_t*)(F.ws + WS_WIN) + (size_t)l * 1536 * 1024, MTOK, DIN, D};
            pg8::StaticOrder S; S.init(MTOK, DIN, F.G, (int)blockIdx.x);
            pg8::EpiScaleBias<0> E{(pg8::bf16_t*)(F.ws + WS_Z), DIN, SS, (const float*)(F.ws + WS_BIAS1) + (size_t)l * 6 * 1536};
            pg8::gemm_phase<pg8::EpiScaleBias<0>, pg8::StaticOrder, true, true>(F.lds + RING_OFF, g, S, E, F.tid);
        }
#endif
        SEAM(pb + 0);
#ifndef NO_M1
        if (IN(pb + 1)) for (int rep_ = 0; rep_ < REP_M; ++rep_) { REFRESH();
            __syncthreads();
            load_t1(F);
            for (int r2_ = 0; r2_ < REP_LRU; ++r2_) lru_phase<false>(F, l);
            for (int r2_ = 0; r2_ < REP_DFT; ++r2_) dft1_phase(F);
        }
#endif
        SEAM(pb + 1);
#ifndef NO_M2
        if (IN(pb + 2)) for (int rep_ = 0; rep_ < REP_M; ++rep_) { REFRESH();
            for (int r2_ = 0; r2_ < REP_LRU; ++r2_) lru_phase<true>(F, l);
            __syncthreads();
            load_t2(F);
            __syncthreads();
            for (int r2_ = 0; r2_ < REP_DFT; ++r2_) dft2_phase(F);
        }
#endif
        SEAM(pb + 2);
#ifndef NO_G2
        if (IN(pb + 3)) { REFRESH();
            pg8::Gemm g{(const pg8::bf16_t*)(F.ws + WS_A2), (const pg8::bf16_t*)(F.ws + WS_WEFF) + (size_t)l * 1024 * 1536, MTOK, D, DIN};
            pg8::StaticOrder S; S.init(MTOK, D, F.G, (int)blockIdx.x);
            pg8::EpiResidual E{l == 0 ? F.in[I_XP] : (const float*)F.out, l == 0 ? F.in[I_XS] : (const float*)F.out + (size_t)16384 * 1024, F.out, (pg8::bf16_t*)(F.ws + WS_A), SS,
                               VEC + (size_t)l * 6 * 4096 + 1 * 1024, VEC + (size_t)l * 6 * 4096 + 2 * 1024};
            pg8::gemm_phase<pg8::EpiResidual, pg8::StaticOrder, true, true>(F.lds + RING_OFF, g, S, E, F.tid);
        }
#endif
        SEAM(pb + 3);
#ifndef NO_G3
        if (IN(pb + 4)) for (int rep_ = 0; rep_ < REP_G3; ++rep_) { REFRESH();
            pg8::Gemm g{(const pg8::bf16_t*)(F.ws + WS_A), (const pg8::bf16_t*)(F.ws + WS_WFF1) + (size_t)l * 4096 * 1024, MTOK, DFF, D};
            pg8::StaticOrder S; S.init(MTOK, DFF, F.G, (int)blockIdx.x);
            pg8::EpiScaleBias<1> E{(pg8::bf16_t*)(F.ws + WS_HMID), DFF, SS, (const float*)(F.ws + WS_BIAS2) + (size_t)l * 6 * 4096};
            pg8::gemm_phase<pg8::EpiScaleBias<1>, pg8::StaticOrder, true, true>(F.lds + RING_OFF, g, S, E, F.tid);
        }
#endif
        SEAM(pb + 4);
#ifndef NO_G4
        if (IN(pb + 5)) { REFRESH();
            pg8::Gemm g{(const pg8::bf16_t*)(F.ws + WS_HMID), (const pg8::bf16_t*)(F.ws + WS_WFF2) + (size_t)l * 1024 * 4096, MTOK, D, DFF};
            pg8::StaticOrder S; S.init(MTOK, D, F.G, (int)blockIdx.x);
            const int ln = l + 1 < DEPTH ? l + 1 : l;
            pg8::EpiResidual E{(const float*)F.out, (const float*)F.out + (size_t)16384 * 1024, F.out, l + 1 < DEPTH ? (pg8::bf16_t*)(F.ws + WS_A) : (pg8::bf16_t*)nullptr, SS,
                               VEC + (size_t)l * 6 * 4096 + 3 * 1024, VEC + (size_t)ln * 6 * 4096 + 0 * 1024};
            pg8::gemm_phase<pg8::EpiResidual, pg8::StaticOrder, true, true>(F.lds + RING_OFF, g, S, E, F.tid);
        }
#endif
        SEAM(pb + 5);
    }
    if (IN(14)) { REFRESH(); final_norm(F); }
#undef IN
#undef SEAM
}

extern "C" void kernel_launch(void* const* d_in, const int* in_sizes, int n_in, void* d_out, int out_size, void* d_ws, size_t ws_size, hipStream_t stream) {
    static int grid = 0;
    if (grid == 0) {
        if (n_in != 21 || out_size != MTOK * D || ws_size < WS_END) { fprintf(stderr, "kernel_launch: built for 21 inputs, %d outputs, >= %zu bytes of workspace; got %d, %d, %zu; nothing launched\n", MTOK * D, (size_t)WS_END, n_in, out_size, ws_size); grid = -1; return; }
        int dev = 0, cus = 0, per_cu = 0;
        if (hipGetDevice(&dev) != hipSuccess || hipDeviceGetAttribute(&cus, hipDeviceAttributeMultiprocessorCount, dev) != hipSuccess) { fprintf(stderr, "kernel_launch: device query failed\n"); grid = -1; return; }
        if (hipFuncSetAttribute((const void*)mk_fwd, hipFuncAttributeMaxDynamicSharedMemorySize, LDS_BYTES) != hipSuccess) { fprintf(stderr, "kernel_launch: hipFuncSetAttribute failed\n"); grid = -1; return; }
        if (hipOccupancyMaxActiveBlocksPerMultiprocessor(&per_cu, (const void*)mk_fwd, NWAVES * 64, LDS_BYTES) != hipSuccess || per_cu < 1) { fprintf(stderr, "kernel_launch: occupancy query reports %d workgroups per CU; nothing launched\n", per_cu); (void)hipGetLastError(); grid = -1; return; }
        (void)hipGetLastError();
        grid = cus;
    }
    if (grid < 0) return;
    (void)hipMemsetAsync((char*)d_ws + WS_CTL, 0, CTL_ZERO_BYTES, stream);
    Args a{};
    for (int i = 0; i < 21; ++i) a.in[i] = (const float*)d_in[i];
    a.out = (float*)d_out; a.ws = (unsigned char*)d_ws;
    if (N_LAUNCHES == 1) { a.ph_lo = 0; a.ph_hi = NPH; hipLaunchKernelGGL(mk_fwd, dim3(grid), dim3(NWAVES * 64), LDS_BYTES, stream, a); }
    else for (int p = 0; p < NPH; ++p) { a.ph_lo = p; a.ph_hi = p + 1; hipLaunchKernelGGL(mk_fwd, dim3(grid), dim3(NWAVES * 64), LDS_BYTES, stream, a); }
}
```

```cpp
#define DBG_ZERO_LDS 1
#define DBG_ZERO_LO 0
#define DBG_ZERO_HI MISC_OFF
#define EPI_RD 4
#include <hip/hip_runtime.h>
#include <cstdio>
#include <cstdint>
#include <cstddef>
namespace pg8 {
#define PG8_LAS __attribute__((address_space(3)))
typedef unsigned short bf16_t;
typedef short bf16x8 __attribute__((ext_vector_type(8)));
typedef float f32x4 __attribute__((ext_vector_type(4)));
typedef unsigned u32x4 __attribute__((ext_vector_type(4)));
constexpr int BM = 256, BK = 64, HALF = 128, HTB = HALF * BK * 2  , STAGE_BYTES = 8 * HTB, NXCD = 8, WGM = 8;

__host__ __device__ __forceinline__ int lds_byte(int r, int c) { const int st = (r >> 4) * 2 + (c >> 5), rr = r & 15, cc = c & 31, ob = rr * 64 + cc * 2; return st * 1024 + (ob ^ (((ob >> 9) & 1) << 5)); }
__host__ __device__ __forceinline__ void stage_rc(int b, int& R, int& C) { const int st = b / 1024, sb = b % 1024, swz = sb ^ (((sb >> 9) & 1) << 5); R = (st >> 1) * 16 + swz / 64; C = (st & 1) * 32 + (swz % 64) / 2; }
__host__ __device__ __forceinline__ int perm32(int rho) { const int n = rho >> 4, i = rho & 15; return 8 * (i >> 2) + 4 * n + (i & 3); }

struct Unit { int pm, pn; };
struct Gemm { const bf16_t* A; const bf16_t* Bt; int M, N, K; size_t bt_seq_stride; };
__device__ __forceinline__ int seq_of_row(int row);

struct StaticOrder {
    int nM, nN, nwg, G, c, rev;
    __host__ __device__ void init(int M, int N, int G_, int c_, int rev_ = 0) { nM = M / BM; nN = N / BM; nwg = nM * nN; G = G_; c = c_; rev = (rev_ && nwg % G == 0) ? 1 : 0; }
    __host__ __device__ bool next(int i, Unit& u) const {
        if (rev) { const int R = nwg / G; if (i >= R) return false; i = R - 1 - i; }
        const long L = (long)i * G + c; if (L >= nwg) return false;
        int wgid = (int)L; { const int q = nwg / NXCD, r = nwg % NXCD, xcd = wgid % NXCD, off = wgid / NXCD; wgid = (xcd < r ? xcd * (q + 1) : r * (q + 1) + (xcd - r) * q) + off; }
        const int nig = WGM * nN, gid = wgid / nig, fm = gid * WGM, gsz = (nM - fm) < WGM ? (nM - fm) : WGM;
        u.pm = fm + ((wgid % nig) % gsz); u.pn = (wgid % nig) / gsz; return true;
    }
    __device__ __forceinline__ void a_ready(const Unit&) const {}
    __device__ __forceinline__ void done(const Unit&) const {}
};

typedef __bf16 bf16x2_n __attribute__((ext_vector_type(2)));
typedef float f32x2_n __attribute__((ext_vector_type(2)));
__device__ __forceinline__ unsigned cvt_pk_bf16(float lo, float hi) { const bf16x2_n v = __builtin_convertvector((f32x2_n){lo, hi}, bf16x2_n); return __builtin_bit_cast(unsigned, v); }
__device__ __forceinline__ int seq_of_row(int row) { return row < 16384 ? (row >> 13) : 2 + ((row - 16384) >> 12); }
constexpr int SS_SLOTS = 16;
#ifndef EPI_RD
#define EPI_RD 5
#endif
#ifndef EPI_SC1
#define EPI_SC1 0
#endif
template <int SC1>
__device__ __forceinline__ void st16(__amdgpu_buffer_rsrc_t rs, void* base, size_t byte_off, u32x4 v) {
    if (SC1) __builtin_amdgcn_raw_buffer_store_b128(v, rs, (int)byte_off, 0, 16);
    else *(u32x4*)((char*)base + byte_off) = v;
}
#ifndef EPI_SC1_RES
#define EPI_SC1_RES 0
#endif
__device__ __forceinline__ float row_rscale(const float* ss, int row) {
    const f32x4* p = (const f32x4*)(ss + (size_t)row * SS_SLOTS);
    f32x4 a = p[0], b = p[1], c = p[2], d = p[3];
    a = (a + b) + (c + d);
    const float s = (a[0] + a[1]) + (a[2] + a[3]);
    return __builtin_amdgcn_rsqf(s * (1.0f / 1024.0f) + 1e-6f);
}
template <int ACT> struct EpiScaleBias {
    static constexpr bool PERM = true, AFTER_DRAIN = false;
    bf16_t* O; int ldc; const float* ss; const float* bias;
    unsigned long long* tel;
    __device__ __forceinline__ void operator()(const f32x4 (&acc)[2][2][4][2], const Unit& u, int wr, int wc, int fr, int fq) const {
#ifdef TEL_A0
        const unsigned long long t0_ = __builtin_amdgcn_s_memrealtime();
#endif
        const int row0 = u.pm * BM + wr * 64 + fr, col0 = u.pn * BM + wc * 32 + 8 * fq;
        const int b = seq_of_row(u.pm * BM);
        const float* bp = bias + (size_t)b * ldc + col0;
        const __amdgpu_buffer_rsrc_t rsO = __builtin_amdgcn_make_buffer_rsrc(O, 0, 0x7ffffff0, 0x00020000);
        f32x4 bv[2][2];
#pragma unroll
        for (int bj = 0; bj < 2; ++bj)
#pragma unroll
            for (int n = 0; n < 2; ++n) bv[bj][n] = *(const f32x4*)(bp + bj * HALF + 4 * n);
        float rs8[2][4];
        { f32x4 sq[2][4];
#pragma unroll
          for (int ai = 0; ai < 2; ++ai)
#pragma unroll
              for (int m = 0; m < 4; ++m) sq[ai][m] = *(const f32x4*)(ss + (size_t)(row0 + ai * HALF + m * 16) * SS_SLOTS + 4 * fq);
#pragma unroll
          for (int ai = 0; ai < 2; ++ai)
#pragma unroll
              for (int m = 0; m < 4; ++m) { float s = (sq[ai][m][0] + sq[ai][m][1]) + (sq[ai][m][2] + sq[ai][m][3]); s += __shfl_xor(s, 16); s += __shfl_xor(s, 32);
                  rs8[ai][m] = __builtin_amdgcn_rsqf(s * (1.0f / 1024.0f) + 1e-6f); } }
#pragma unroll
        for (int ai = 0; ai < 2; ++ai)
#pragma unroll
            for (int m = 0; m < 4; ++m) { const int row = row0 + ai * HALF + m * 16; const float r = rs8[ai][m];
                const size_t rowb = ((size_t)row * ldc + col0) * 2;
#pragma unroll
                for (int bj = 0; bj < 2; ++bj) { f32x4 v0 = acc[ai][bj][m][0] * r + bv[bj][0], v1 = acc[ai][bj][m][1] * r + bv[bj][1];
                    if (ACT == 1) {
#pragma unroll
                        for (int j = 0; j < 4; ++j) { v0[j] = fmaxf(v0[j], 0.f); v1[j] = fmaxf(v1[j], 0.f); }
                        v0 = v0 * v0; v1 = v1 * v1; }
                    u32x4 w; w.x = cvt_pk_bf16(v0[0], v0[1]); w.y = cvt_pk_bf16(v0[2], v0[3]); w.z = cvt_pk_bf16(v1[0], v1[1]); w.w = cvt_pk_bf16(v1[2], v1[3]);
                    st16<EPI_SC1>(rsO, O, rowb + bj * HALF * 2, w); } }
#ifdef TEL_A0
        if (tel && blockIdx.x == 0 && threadIdx.x == 0) *tel += __builtin_amdgcn_s_memrealtime() - t0_;
#endif
    }
};
template <bool X32, bool LAST = false> struct EpiResidual {
    static constexpr bool PERM = true, AFTER_DRAIN = false;
    const void* xin0; const void* xin1;
    bf16_t* xout; bf16_t* An; float* ss; const float* gate; const float* alpha;
    unsigned long long* tel;
    int last;
    __device__ __forceinline__ void operator()(const f32x4 (&acc)[2][2][4][2], const Unit& u, int wr, int wc, int fr, int fq) const {
#ifdef TEL_A0
        const unsigned long long t0_ = __builtin_amdgcn_s_memrealtime();
#endif
        const int row0 = u.pm * BM + wr * 64 + fr, col0 = u.pn * BM + wc * 32 + 8 * fq;
        const int b = seq_of_row(u.pm * BM);
        f32x4 gv[2][2], av[2][2];
#pragma unroll
        for (int bj = 0; bj < 2; ++bj)
#pragma unroll
            for (int n = 0; n < 2; ++n) { gv[bj][n] = *(const f32x4*)(gate + (size_t)b * 4096 + col0 + bj * HALF + 4 * n); av[bj][n] = *(const f32x4*)(alpha + (size_t)b * 4096 + col0 + bj * HALF + 4 * n); }
        constexpr int RD = X32 ? 3 : EPI_RD, NV = X32 ? 4 : 2;
        u32x4 xb[RD][NV];
#define EPIRES_LOADX(slot, it) do { const int row_ = row0 + ((it) >> 2) * HALF + ((it) & 3) * 16; \
            if (X32) { const float* xr_ = (row_ < 16384 ? (const float*)xin0 + (size_t)row_ * 1024 : (const float*)xin1 + (size_t)(row_ - 16384) * 1024) + col0; \
                xb[slot][0] = *(const u32x4*)(xr_); xb[slot][1] = *(const u32x4*)(xr_ + 4); xb[slot][NV - 2] = *(const u32x4*)(xr_ + HALF); xb[slot][NV - 1] = *(const u32x4*)(xr_ + HALF + 4); } \
            else { const bf16_t* xr_ = (const bf16_t*)xin0 + (size_t)row_ * 1024 + col0; xb[slot][0] = *(const u32x4*)(xr_); xb[slot][1] = *(const u32x4*)(xr_ + HALF); } } while (0)
#pragma unroll
        for (int it = 0; it < RD; ++it) EPIRES_LOADX(it, it);
#pragma unroll
        for (int it = 0; it < 8; ++it) { const int ai = it >> 2, m = it & 3, row = row0 + ai * HALF + m * 16;
                float sp = 0.f;
#pragma unroll
                for (int bj = 0; bj < 2; ++bj) {
                    f32x4 x0, x1;
                    if (X32) { x0 = __builtin_bit_cast(f32x4, xb[it % RD][bj * 2]); x1 = __builtin_bit_cast(f32x4, xb[it % RD][bj * 2 + 1]); }
                    else { const u32x4 r = xb[it % RD][bj];
                        x0 = (f32x4){__builtin_bit_cast(float, r.x << 16), __builtin_bit_cast(float, r.x & 0xffff0000u), __builtin_bit_cast(float, r.y << 16), __builtin_bit_cast(float, r.y & 0xffff0000u)};
                        x1 = (f32x4){__builtin_bit_cast(float, r.z << 16), __builtin_bit_cast(float, r.z & 0xffff0000u), __builtin_bit_cast(float, r.w << 16), __builtin_bit_cast(float, r.w & 0xffff0000u)}; }
                    const f32x4 y0 = x0 + gv[bj][0] * acc[ai][bj][m][0], y1 = x1 + gv[bj][1] * acc[ai][bj][m][1];
                    { const f32x4 q = y0 * y0 + y1 * y1; sp += (q[0] + q[1]) + (q[2] + q[3]); }
                    if (!LAST) { u32x4 w; w.x = cvt_pk_bf16(y0[0], y0[1]); w.y = cvt_pk_bf16(y0[2], y0[3]); w.z = cvt_pk_bf16(y1[0], y1[1]); w.w = cvt_pk_bf16(y1[2], y1[3]);
                        *(u32x4*)(xout + (size_t)row * 1024 + col0 + bj * HALF) = w; }
                    { const f32x4 a0 = LAST ? y0 : y0 * av[bj][0], a1 = LAST ? y1 : y1 * av[bj][1];
                        u32x4 w; w.x = cvt_pk_bf16(a0[0], a0[1]); w.y = cvt_pk_bf16(a0[2], a0[3]); w.z = cvt_pk_bf16(a1[0], a1[1]); w.w = cvt_pk_bf16(a1[2], a1[3]);
                        *(u32x4*)(An + (size_t)row * 1024 + col0 + bj * HALF) = w; } }
                sp += __shfl_xor(sp, 16); sp += __shfl_xor(sp, 32);
                if (fq == 0) ss[(size_t)row * SS_SLOTS + u.pn * 4 + wc] = sp;
                if (it + RD < 8) EPIRES_LOADX(it % RD, it + RD); }
#undef EPIRES_LOADX
#ifdef TEL_A0
        if (tel && blockIdx.x == 0 && threadIdx.x == 0) *tel += __builtin_amdgcn_s_memrealtime() - t0_;
#endif
    }
};
template <class Epi, class Sched, bool ALIGN_EPI = false, bool SP2 = false>
__device__ __forceinline__ void gemm_phase(PG8_LAS unsigned char* lds, const Gemm g, const Sched& S, const Epi& E, const int tid, const bool bpre = false) {
    const int wid = __builtin_amdgcn_readfirstlane(tid >> 6), lane = tid & 63, wr = wid >> 2, wc = wid & 3, fr = lane & 15, fq = lane >> 4;
    const int K = g.K, nt = K / BK;
    unsigned voffA[2], voffB[2];
#pragma unroll
    for (int i = 0; i < 2; ++i) { int R, C; stage_rc(tid * 16 + i * 8192, R, C); const int Rb = Epi::PERM ? ((R & ~31) + perm32(R & 31)) : R;
        voffA[i] = (unsigned)(R * K + C) * 2u; voffB[i] = (unsigned)(Rb * K + C) * 2u; }
    const size_t kstep = (size_t)(BK * 2);
    const size_t hstep = (size_t)HALF * K * 2;
    const size_t tstep = 2 * hstep;
    const unsigned ldsw = (unsigned)wid * 1024u;
    const int aoff = lds_byte(wr * 64 + fr, fq * 8), boff = lds_byte(wc * 32 + fr, fq * 8);
#define PG8_SA(b, h) (((b) * 2 + (h)) * HTB)
#define PG8_SB(b, h) ((4 + (b) * 2 + (h)) * HTB)
#define PG8_STAGE(bufoff, gbase, voff) do { _Pragma("unroll") for (int _i = 0; _i < 2; ++_i) \
        __builtin_amdgcn_global_load_lds((const unsigned*)((const char*)(gbase) + (voff)[_i]), (PG8_LAS unsigned*)(lds + (bufoff) + ldsw + _i * 8192), 16, 0, 0); } while (0)
#define PG8_LDA(dst, b, h) do { _Pragma("unroll") for (int m = 0; m < 4; ++m) _Pragma("unroll") for (int k = 0; k < 2; ++k) dst[m][k] = *(const PG8_LAS bf16x8*)(lds + PG8_SA(b, h) + aoff + m * 2048 + k * 1024); } while (0)
#define PG8_LDB(dst, b, h) do { _Pragma("unroll") for (int n = 0; n < 2; ++n) _Pragma("unroll") for (int k = 0; k < 2; ++k) dst[n][k] = *(const PG8_LAS bf16x8*)(lds + PG8_SB(b, h) + boff + n * 2048 + k * 1024); } while (0)
#define PG8_MMA(ai, bj, At, Bt) do { __builtin_amdgcn_s_setprio(1); _Pragma("unroll") for (int m = 0; m < 4; ++m) _Pragma("unroll") for (int n = 0; n < 2; ++n) _Pragma("unroll") for (int k = 0; k < 2; ++k) \
        acc[ai][bj][m][n] = __builtin_amdgcn_mfma_f32_16x16x32_bf16(Bt[n][k], At[m][k], acc[ai][bj][m][n], 0, 0, 0); __builtin_amdgcn_s_setprio(0); } while (0)
#define PG8_WAIT_V(n) asm volatile("s_waitcnt vmcnt(" #n ")" ::: "memory")
#define PG8_WAIT_L(n) asm volatile("s_waitcnt lgkmcnt(" #n ")" ::: "memory")
#define PG8_BAR __builtin_amdgcn_s_barrier()
#define PG8_SCHED __builtin_amdgcn_sched_barrier(0)
    Unit cur, nxt; int ui = 0;
    if (!S.next(0, cur)) return;
    f32x4 acc[2][2][4][2];
#pragma unroll
    for (int a = 0; a < 2; ++a)
#pragma unroll
        for (int b = 0; b < 2; ++b)
#pragma unroll
            for (int m = 0; m < 4; ++m)
#pragma unroll
                for (int n = 0; n < 2; ++n) acc[a][b][m][n] = (f32x4){0.f, 0.f, 0.f, 0.f};
    bf16x8 At[4][2], B0[2][2], B1[2][2];
    const char* cA = (const char*)g.A + (size_t)cur.pm * tstep; const char* cB = (const char*)g.Bt + (size_t)cur.pn * tstep + (size_t)seq_of_row(cur.pm * BM) * g.bt_seq_stride;
    S.a_ready(cur);
    if constexpr (SP2) {
        if (bpre && wid != 0) {
            PG8_STAGE(PG8_SA(0, 0), cA, voffA); PG8_STAGE(PG8_SA(0, 1), cA + hstep, voffA);
            if (wr == 1) PG8_BAR;
            PG8_WAIT_V(2); PG8_BAR;
            PG8_STAGE(PG8_SA(1, 0), cA + kstep, voffA);
            PG8_WAIT_V(2); PG8_BAR;
        } else {
        PG8_STAGE(PG8_SB(0, 0), cB, voffB); PG8_STAGE(PG8_SB(0, 1), cB + hstep, voffB); PG8_STAGE(PG8_SA(0, 0), cA, voffA); PG8_STAGE(PG8_SA(0, 1), cA + hstep, voffA);
        if (wr == 1) PG8_BAR;
        PG8_WAIT_V(2); PG8_BAR;
        PG8_STAGE(PG8_SB(1, 0), cB + kstep, voffB); PG8_STAGE(PG8_SA(1, 0), cA + kstep, voffA); PG8_STAGE(PG8_SB(1, 1), cB + hstep + kstep, voffB);
        PG8_WAIT_V(6); PG8_BAR;
        }
    } else {
        PG8_STAGE(PG8_SB(0, 0), cB, voffB); PG8_STAGE(PG8_SA(0, 0), cA, voffA); PG8_STAGE(PG8_SB(0, 1), cB + hstep, voffB); PG8_STAGE(PG8_SA(0, 1), cA + hstep, voffA);
        if (wr == 1) PG8_BAR;
        PG8_WAIT_V(4); PG8_BAR;
        PG8_STAGE(PG8_SB(1, 0), cB + kstep, voffB); PG8_STAGE(PG8_SA(1, 0), cA + kstep, voffA); PG8_STAGE(PG8_SB(1, 1), cB + hstep + kstep, voffB);
        PG8_WAIT_V(6); PG8_BAR;
    }
    for (;;) {
#ifdef TEL_A0
        const unsigned long long tu_ = __builtin_amdgcn_s_memrealtime();
#endif
        const bool has_next = S.next(ui + 1, nxt);
        const char* nA = has_next ? (const char*)g.A + (size_t)nxt.pm * tstep : cA; const char* nB = has_next ? (const char*)g.Bt + (size_t)nxt.pn * tstep + (size_t)seq_of_row(nxt.pm * BM) * g.bt_seq_stride : cB;
        for (int t = 0; t < nt; t += 2) {
            const bool last = (t == nt - 2);
            const char* a1 = cA + (size_t)(t + 1) * kstep;
            const char* a2 = last ? nA : cA + (size_t)(t + 2) * kstep; const char* b2 = last ? nB : cB + (size_t)(t + 2) * kstep;
            const char* a3 = a2 + kstep; const char* b3 = b2 + kstep;
            if (last && has_next) S.a_ready(nxt);
            if constexpr (SP2) {
            PG8_LDB(B0, 0, 0); PG8_LDB(B1, 0, 1); PG8_SCHED; PG8_LDA(At, 0, 0); PG8_STAGE(PG8_SA(1, 1), a1 + hstep, voffA);
            PG8_WAIT_V(8); PG8_WAIT_L(0); PG8_BAR; PG8_MMA(0, 0, At, B0); PG8_MMA(0, 1, At, B1); PG8_BAR; PG8_SCHED;
            PG8_LDA(At, 0, 1); PG8_STAGE(PG8_SB(0, 0), b2, voffB); PG8_STAGE(PG8_SB(0, 1), b2 + hstep, voffB); PG8_STAGE(PG8_SA(0, 0), a2, voffA);
            PG8_WAIT_V(8); PG8_WAIT_L(0); PG8_BAR; PG8_MMA(1, 0, At, B0); PG8_MMA(1, 1, At, B1); PG8_BAR; PG8_SCHED;
            PG8_LDB(B0, 1, 0); PG8_LDB(B1, 1, 1); PG8_SCHED; PG8_LDA(At, 1, 0); PG8_STAGE(PG8_SA(0, 1), a2 + hstep, voffA);
            PG8_WAIT_V(8); PG8_WAIT_L(0); PG8_BAR; PG8_MMA(0, 0, At, B0); PG8_MMA(0, 1, At, B1); PG8_BAR; PG8_SCHED;
            PG8_LDA(At, 1, 1); PG8_STAGE(PG8_SB(1, 0), b3, voffB); PG8_STAGE(PG8_SB(1, 1), b3 + hstep, voffB); PG8_STAGE(PG8_SA(1, 0), a3, voffA);
            PG8_WAIT_V(8); PG8_WAIT_L(0); PG8_BAR; PG8_MMA(1, 0, At, B0); PG8_MMA(1, 1, At, B1); PG8_BAR; PG8_SCHED;
            } else {
            PG8_LDB(B0, 0, 0); PG8_SCHED; PG8_LDA(At, 0, 0); PG8_STAGE(PG8_SA(1, 1), a1 + hstep, voffA);
            PG8_WAIT_L(8); PG8_BAR; PG8_WAIT_L(0); PG8_MMA(0, 0, At, B0); PG8_BAR; PG8_SCHED;
            PG8_LDB(B1, 0, 1); PG8_STAGE(PG8_SB(0, 0), b2, voffB);
            PG8_BAR; PG8_WAIT_L(0); PG8_MMA(0, 1, At, B1); PG8_BAR;
            PG8_LDA(At, 0, 1); PG8_STAGE(PG8_SA(0, 0), a2, voffA);
            PG8_BAR; PG8_WAIT_L(0); PG8_MMA(1, 0, At, B0); PG8_BAR; PG8_SCHED;
            PG8_STAGE(PG8_SB(0, 1), b2 + hstep, voffB);
            PG8_WAIT_V(6); PG8_BAR; PG8_MMA(1, 1, At, B1); PG8_BAR;
            PG8_LDB(B0, 1, 0); PG8_SCHED; PG8_LDA(At, 1, 0); PG8_STAGE(PG8_SA(0, 1), a2 + hstep, voffA);
            PG8_WAIT_L(8); PG8_BAR; PG8_WAIT_L(0); PG8_MMA(0, 0, At, B0); PG8_BAR; PG8_SCHED;
            PG8_LDB(B1, 1, 1); PG8_STAGE(PG8_SB(1, 0), b3, voffB);
            PG8_BAR; PG8_WAIT_L(0); PG8_MMA(0, 1, At, B1); PG8_BAR;
            PG8_LDA(At, 1, 1); PG8_STAGE(PG8_SA(1, 0), a3, voffA);
            PG8_BAR; PG8_WAIT_L(0); PG8_MMA(1, 0, At, B0); PG8_BAR; PG8_SCHED;
            PG8_STAGE(PG8_SB(1, 1), b3 + hstep, voffB);
            PG8_WAIT_V(6); PG8_BAR; PG8_MMA(1, 1, At, B1); PG8_BAR;
            }
        }
        if constexpr (ALIGN_EPI) { if (wr == 0) PG8_BAR; }
#ifdef TEL_A0
        if (E.tel && blockIdx.x == 0 && tid == 0) E.tel[32] += __builtin_amdgcn_s_memrealtime() - tu_;
#endif
        if constexpr (!Epi::AFTER_DRAIN) { E(acc, cur, wr, wc, fr, fq); S.done(cur); }
        if (!has_next) break;
#pragma unroll
        for (int a = 0; a < 2; ++a)
#pragma unroll
            for (int b = 0; b < 2; ++b)
#pragma unroll
                for (int m = 0; m < 4; ++m)
#pragma unroll
                    for (int n = 0; n < 2; ++n) acc[a][b][m][n] = (f32x4){0.f, 0.f, 0.f, 0.f};
        cur = nxt; cA = nA; cB = nB; ++ui;
        if constexpr (ALIGN_EPI) { if (wr == 1) PG8_BAR; }
    }
    PG8_WAIT_V(0);
    if constexpr (!ALIGN_EPI) { if (wr == 0) PG8_BAR; }
    PG8_BAR;
    if constexpr (Epi::AFTER_DRAIN) { E.fused(acc, cur, wr, wc, fr, fq, lds, wid, lane); S.done(cur); }
#undef PG8_SA
#undef PG8_SB
#undef PG8_STAGE
#undef PG8_LDA
#undef PG8_LDB
#undef PG8_MMA
#undef PG8_WAIT_V
#undef PG8_WAIT_L
#undef PG8_BAR
#undef PG8_SCHED
}
template <bool PERM, class Sched>
__device__ __forceinline__ void gemm_prefetch_b(PG8_LAS unsigned char* lds, const Gemm g, const Sched& S, const int tid) {
    Unit cur; if (!S.next(0, cur)) return;
    const int wid = __builtin_amdgcn_readfirstlane(tid >> 6); const int K = g.K;
    if (wid == 0) return;
    const size_t kstep = (size_t)(BK * 2), hstep = (size_t)HALF * K * 2, tstep = 2 * hstep;
    const unsigned ldsw = (unsigned)wid * 1024u;
    const char* cB = (const char*)g.Bt + (size_t)cur.pn * tstep + (size_t)seq_of_row(cur.pm * BM) * g.bt_seq_stride;
#pragma unroll
    for (int i = 0; i < 2; ++i) { int R, C; stage_rc(tid * 16 + i * 8192, R, C); const int Rb = PERM ? ((R & ~31) + perm32(R & 31)) : R; const unsigned vo = (unsigned)(Rb * K + C) * 2u;
        __builtin_amdgcn_global_load_lds((const unsigned*)(cB + vo), (PG8_LAS unsigned*)(lds + (4 + 0) * HTB + ldsw + i * 8192), 16, 0, 0);
        __builtin_amdgcn_global_load_lds((const unsigned*)(cB + hstep + vo), (PG8_LAS unsigned*)(lds + (4 + 1) * HTB + ldsw + i * 8192), 16, 0, 0);
        __builtin_amdgcn_global_load_lds((const unsigned*)(cB + kstep + vo), (PG8_LAS unsigned*)(lds + (4 + 2) * HTB + ldsw + i * 8192), 16, 0, 0);
        __builtin_amdgcn_global_load_lds((const unsigned*)(cB + hstep + kstep + vo), (PG8_LAS unsigned*)(lds + (4 + 3) * HTB + ldsw + i * 8192), 16, 0, 0); }
}

}
#define GAS __attribute__((address_space(1)))
#define LAS __attribute__((address_space(3)))
typedef unsigned short bf16;
typedef unsigned v4u __attribute__((ext_vector_type(4)));
typedef unsigned v2u __attribute__((ext_vector_type(2)));
typedef float f32x4 __attribute__((ext_vector_type(4)));
typedef float f32x2 __attribute__((ext_vector_type(2)));
typedef float f32x16 __attribute__((ext_vector_type(16)));
typedef short bf16x8 __attribute__((ext_vector_type(8)));
typedef GAS unsigned gu32;
#define RLX_AGENT __ATOMIC_RELAXED, __HIP_MEMORY_SCOPE_AGENT
#define LDS_WAIT() asm volatile("s_waitcnt lgkmcnt(0)" ::: "memory")
#define VM_WAIT() asm volatile("s_waitcnt vmcnt(0)" ::: "memory")

constexpr int NWAVES = 8;
#ifndef MK_N_LAUNCHES
#define MK_N_LAUNCHES 1
#endif
constexpr int NPH = 15;
constexpr int N_LAUNCHES = MK_N_LAUNCHES;

constexpr int D = 1024, DIN = 1536, DFF = 4096, MTOK = 32768, NSEQ = 6, DEPTH = 2;
__device__ __forceinline__ int seq_tok0(int b) { return b < 2 ? b * 8192 : 16384 + (b - 2) * 4096; }
__device__ __forceinline__ int seq_len(int b) { return b < 2 ? 8192 : 4096; }

constexpr size_t MiB = 1u << 20, KiB = 1u << 10;
constexpr size_t WS_CTL = 0, CTL_ZERO_BYTES = 1 * MiB;
constexpr size_t WS_MOD = 1 * MiB;
constexpr size_t WS_VEC = 1 * MiB + 512 * KiB;
constexpr size_t WS_BIAS1 = 2 * MiB;
constexpr size_t WS_BIAS2 = 2 * MiB + 128 * KiB;
constexpr size_t WS_CL = 2 * MiB + 512 * KiB;
constexpr size_t WS_TW = 3 * MiB;
constexpr size_t WS_T1 = 3 * MiB + 128 * KiB;
constexpr size_t WS_T2 = 3 * MiB + 160 * KiB;
constexpr size_t WS_WCT = 3 * MiB + 256 * KiB;
constexpr size_t WS_WG = 4 * MiB;
constexpr size_t WS_AGG = 384 * MiB;
constexpr size_t WS_SS = 8 * MiB;
constexpr size_t WS_WIN = 16 * MiB;
constexpr size_t WS_WEFF = 22 * MiB;
constexpr size_t WS_WFF1 = 28 * MiB;
constexpr size_t WS_WFF2 = 44 * MiB;
constexpr size_t WS_A = 64 * MiB;
constexpr size_t WS_Z = 128 * MiB;
constexpr size_t WS_A2 = 224 * MiB;
constexpr size_t WS_H = 320 * MiB;
constexpr size_t WS_HMID = 128 * MiB;
constexpr size_t WS_WIN0 = 392 * MiB;
constexpr size_t WS_END = 410 * MiB;
constexpr int CW_BAR = 4096;

constexpr int RING_OFF = 0, RING_BYTES = 131072;
constexpr int LDS_BYTES = 163840, MISC_OFF = LDS_BYTES - 256;
constexpr int L_WG = 0;
constexpr int L_PAR = 46080;
constexpr int L_AGG = 49152;
constexpr int L_CU = 57344;
constexpr int L_T1 = 59392;
constexpr int L_T2 = 77824;
constexpr int L_T2S = L_T2 + 128 * 136 * 2;
constexpr int L_STREAM = L_T2;
constexpr int L_YT = L_T2 + 32768;
static_assert(L_YT + 8 * 4608 <= L_T2 + 2 * 128 * 136 * 2, "LRU scratch inside the T2 region");
static_assert(L_T2S + 128 * 136 * 2 <= MISC_OFF, "LDS map");

#define XB_TMO      128
#define XB_XCNT(j)  (256  + 64 * (j))
#define XB_XSUB(j)  (1280 + 64 * (j))
#define XB_XGEN(j)  (2304 + 64 * (j))
#define XB_TOP      3328
#define XB_TOPGEN   3392
#define XCD_BAR_WORDS 3456
#define XB_SPIN_CAP (1u << 18)
__device__ __forceinline__ unsigned xb_ld(unsigned* p)              { return __hip_atomic_load(p, __ATOMIC_RELAXED, __HIP_MEMORY_SCOPE_AGENT); }
__device__ __forceinline__ unsigned xb_add(unsigned* p, unsigned v) { return __hip_atomic_fetch_add(p, v, __ATOMIC_RELAXED, __HIP_MEMORY_SCOPE_AGENT); }
__device__ __forceinline__ unsigned xb_xcc_id() { return (unsigned)__builtin_amdgcn_s_getreg((3 << 11) | 20) & 0xFu; }
#define XB_SPIN(cond, bar) do { unsigned _sp = 0; while (cond) { __builtin_amdgcn_s_sleep(1); \
    if ((++_sp & 255u) == 0u) { if (xb_ld(&(bar)[XB_TMO])) break; if (_sp > XB_SPIN_CAP) { atomicAdd(&(bar)[XB_TMO], 1u); break; } } } } while (0)
struct XcdBarrier { unsigned* bar; unsigned x; volatile LAS unsigned* st; };
__device__ __forceinline__ XcdBarrier xcd_barrier_post(unsigned* bar, volatile LAS unsigned* st) {
    XcdBarrier b; b.bar = bar; b.x = xb_xcc_id(); b.st = st;
    if (threadIdx.x == 0) (void)xb_add(&bar[XB_XCNT(b.x)], 1u);
    return b;
}
__device__ __forceinline__ void xcd_barrier_complete(unsigned* bar, unsigned x, unsigned& nloc, unsigned& nx) {
    const unsigned G = gridDim.x * gridDim.y * gridDim.z;
    unsigned sum, cnt, mine, sp = 0u;
    for (;;) {
        sum = 0u; cnt = 0u; mine = 0u;
#pragma unroll
        for (unsigned j = 0; j < 16; ++j) { const unsigned c = xb_ld(&bar[XB_XCNT(j)]); sum += c; cnt += (c > 0u) ? 1u : 0u; mine = (j == x) ? c : mine; }
        if (sum == G) break;
        __builtin_amdgcn_s_sleep(1);
        if ((++sp & 255u) == 0u) { if (xb_ld(&bar[XB_TMO])) break; if (sp > XB_SPIN_CAP) { atomicAdd(&bar[XB_TMO], 1u); break; } }
    }
    nloc = mine > 0u ? mine : 1u; nx = cnt > 0u ? cnt : 1u;
}
__device__ __forceinline__ void xcd_barrier(const XcdBarrier& b) {
    asm volatile("s_waitcnt vmcnt(0)" ::: "memory");
    __syncthreads();
    if (threadIdx.x == 0) {
        unsigned* bar = b.bar;
        __builtin_amdgcn_s_waitcnt(0);
        unsigned nloc = b.st[0], nx = b.st[1];
        if (nloc == 0u) { xcd_barrier_complete(bar, b.x, nloc, nx); b.st[0] = nloc; b.st[1] = nx; }
        const unsigned old = xb_add(&bar[XB_XSUB(b.x)], 1u);
        const unsigned gen = old / nloc;
        if (old + 1u == (gen + 1u) * nloc) {
            __builtin_amdgcn_fence(__ATOMIC_RELEASE, "agent");
            asm volatile("s_waitcnt vmcnt(0)" ::: "memory");
            const unsigned og = xb_add(&bar[XB_TOP], 1u);
            const unsigned tg = og / nx;
            if (og + 1u == (tg + 1u) * nx) xb_add(&bar[XB_TOPGEN], 1u);
            else XB_SPIN(xb_ld(&bar[XB_TOPGEN]) == tg, bar);
            __builtin_amdgcn_fence(__ATOMIC_ACQUIRE, "agent");
            xb_add(&bar[XB_XGEN(b.x)], 1u);
            asm volatile("s_waitcnt vmcnt(0)" ::: "memory");
        } else {
            XB_SPIN(xb_ld(&bar[XB_XGEN(b.x)]) == gen, bar);
            __builtin_amdgcn_fence(__ATOMIC_ACQUIRE, "agent");
            asm volatile("s_waitcnt vmcnt(0)" ::: "memory");
        }
    }
    __syncthreads();
}
template <class Hook>
__device__ __forceinline__ void xcd_barrier_h(const XcdBarrier& b, const Hook& hook) {
    asm volatile("s_waitcnt vmcnt(0)" ::: "memory");
    __syncthreads();
    hook();
    if (threadIdx.x == 0) {
        unsigned* bar = b.bar;
        __builtin_amdgcn_s_waitcnt(0);
        unsigned nloc = b.st[0], nx = b.st[1];
        if (nloc == 0u) { xcd_barrier_complete(bar, b.x, nloc, nx); b.st[0] = nloc; b.st[1] = nx; }
        const unsigned old = xb_add(&bar[XB_XSUB(b.x)], 1u);
        const unsigned gen = old / nloc;
        if (old + 1u == (gen + 1u) * nloc) {
            __builtin_amdgcn_fence(__ATOMIC_RELEASE, "agent");
            asm volatile("s_waitcnt vmcnt(0)" ::: "memory");
            const unsigned og = xb_add(&bar[XB_TOP], 1u);
            const unsigned tg = og / nx;
            if (og + 1u == (tg + 1u) * nx) xb_add(&bar[XB_TOPGEN], 1u);
            else XB_SPIN(xb_ld(&bar[XB_TOPGEN]) == tg, bar);
            __builtin_amdgcn_fence(__ATOMIC_ACQUIRE, "agent");
            xb_add(&bar[XB_XGEN(b.x)], 1u);
            asm volatile("s_waitcnt vmcnt(0)" ::: "memory");
        } else {
            XB_SPIN(xb_ld(&bar[XB_XGEN(b.x)]) == gen, bar);
            __builtin_amdgcn_fence(__ATOMIC_ACQUIRE, "agent");
            asm volatile("s_waitcnt vmcnt(0)" ::: "memory");
        }
    }
    __syncthreads();
}

typedef __bf16 bf16x2_t __attribute__((ext_vector_type(2)));
__device__ __forceinline__ unsigned f2bf(float f) { const __bf16 v = (__bf16)f; return (unsigned)__builtin_bit_cast(unsigned short, v); }
__device__ __forceinline__ unsigned pk2(float lo, float hi) { const bf16x2_t v = __builtin_convertvector((f32x2){lo, hi}, bf16x2_t); return __builtin_bit_cast(unsigned, v); }
__device__ __forceinline__ float bflo(unsigned w) { return __builtin_bit_cast(float, w << 16); }
__device__ __forceinline__ float bfhi(unsigned w) { return __builtin_bit_cast(float, w & 0xffff0000u); }
__device__ __forceinline__ float wave_sum(float v) {
#pragma unroll
    for (int o = 1; o < 64; o <<= 1) v += __shfl_xor(v, o);
    return v;
}
__device__ __forceinline__ float sigmoidf_fast(float x) { return __builtin_amdgcn_rcpf(1.0f + __builtin_amdgcn_exp2f(-1.44269504089f * x)); }

struct Frame {
    LAS unsigned char* lds;
    volatile LAS unsigned* MISC;
    gu32* ctl;
    int tid, lane, wave;
    int vcu, G;
    const float* in[21];
    float* out; unsigned char* ws;
};
enum { I_XP = 0, I_XS, I_CP, I_CS, I_GMIX, I_GMLP, I_WMOD, I_BMOD, I_WIN, I_WF, I_CONVW, I_CONVB, I_WRG, I_BRG, I_WIG, I_BIG, I_LAM, I_WOUT, I_WFF1, I_WFF2, I_GFIN };

#ifdef TEL_A0
#define PSTAMP(i) do { if (blockIdx.x == 0 && F.tid == 0) ((unsigned long long*)(F.ws + WS_CTL + 65536))[i] = __builtin_amdgcn_s_memrealtime(); } while (0)
#else
#define PSTAMP(i) do { } while (0)
#endif
__device__ __forceinline__ void p0_transpose_item(const float* W, int ldn, int nsub, bf16* WT, int ldd, int koff, int row_off, LAS float* scr, int item, int lane) {
    const int nblk = nsub / 64, kb = item / nblk, nb = item % nblk, k0 = 64 * kb, n0 = 64 * nb;
    const int r4 = lane >> 4, cq = lane & 15;
    f32x4 v[16];
#pragma unroll
    for (int i = 0; i < 16; ++i) v[i] = *(const GAS f32x4*)(W + (size_t)(k0 + 4 * i + r4) * ldn + n0 + 4 * cq);
#pragma unroll
    for (int i = 0; i < 16; ++i) { LAS float* d = scr + (4 * i + r4) * 65 + 4 * cq; d[0] = v[i][0]; d[1] = v[i][1]; d[2] = v[i][2]; d[3] = v[i][3]; }
    LDS_WAIT(); asm volatile("" ::: "memory");
    const int c = lane & 7;
#pragma unroll
    for (int j = 0; j < 8; ++j) { const int n = (lane >> 3) + 8 * j; const LAS float* s = scr + (8 * c) * 65 + n;
        v4u o; o.x = pk2(s[0 * 65], s[1 * 65]); o.y = pk2(s[2 * 65], s[3 * 65]); o.z = pk2(s[4 * 65], s[5 * 65]); o.w = pk2(s[6 * 65], s[7 * 65]);
        *(GAS v4u*)(WT + (size_t)(row_off + n0 + n) * ldd + koff + k0 + 8 * c) = o; }
    LDS_WAIT(); asm volatile("" ::: "memory");
}
__device__ __forceinline__ void p0_transpose_item_scaled(const float* W, const float* gmix, const float* MOD, bf16* WT6, LAS float* scr, int item, int lane) {
    const int nblk = 1536 / 64, kb = item / nblk, nb = item % nblk, k0 = 64 * kb, n0 = 64 * nb;
    const int r4 = lane >> 4, cq = lane & 15;
    f32x4 v[16];
#pragma unroll
    for (int i = 0; i < 16; ++i) v[i] = *(const GAS f32x4*)(W + (size_t)(k0 + 4 * i + r4) * 1536 + n0 + 4 * cq);
#pragma unroll
    for (int i = 0; i < 16; ++i) { LAS float* d = scr + (4 * i + r4) * 65 + 4 * cq; d[0] = v[i][0]; d[1] = v[i][1]; d[2] = v[i][2]; d[3] = v[i][3]; }
    LDS_WAIT(); asm volatile("" ::: "memory");
    const int c = lane & 7;
    const f32x4 g0 = *(const f32x4*)(gmix + k0 + 8 * c), g1 = *(const f32x4*)(gmix + k0 + 8 * c + 4);
#pragma unroll 1
    for (int b = 0; b < 6; ++b) {
        const float* sc = MOD + (size_t)b * 6144 + 1024 + k0 + 8 * c;
        const f32x4 a0 = g0 * (1.0f + *(const f32x4*)sc), a1 = g1 * (1.0f + *(const f32x4*)(sc + 4));
#pragma unroll
        for (int j = 0; j < 8; ++j) { const int n = (lane >> 3) + 8 * j; const LAS float* s = scr + (8 * c) * 65 + n;
            v4u o; o.x = pk2(s[0 * 65] * a0[0], s[1 * 65] * a0[1]); o.y = pk2(s[2 * 65] * a0[2], s[3 * 65] * a0[3]); o.z = pk2(s[4 * 65] * a1[0], s[5 * 65] * a1[1]); o.w = pk2(s[6 * 65] * a1[2], s[7 * 65] * a1[3]);
            *(GAS v4u*)(WT6 + (size_t)b * 1536 * 1024 + (size_t)(n0 + n) * 1024 + k0 + 8 * c) = o; }
    }
    LDS_WAIT(); asm volatile("" ::: "memory");
}
__device__ __forceinline__ void gemv6_wave(const float* W, size_t ldn, const LAS float* vec, int kbase, int lane, f32x4 (&acc)[6]) {
    const int ksub = lane >> 4, cq = lane & 15;
#pragma unroll
    for (int b = 0; b < 6; ++b) acc[b] = (f32x4){0.f, 0.f, 0.f, 0.f};
    const float* wp = W + (size_t)(kbase + ksub) * ldn + 4 * cq;
#pragma unroll 8
    for (int i = 0; i < 32; ++i) { const f32x4 w = *(const GAS f32x4*)(wp + (size_t)(4 * i) * ldn);
#pragma unroll
        for (int b = 0; b < 6; ++b) acc[b] += w * vec[b * 1024 + kbase + 4 * i + ksub]; }
#pragma unroll
    for (int b = 0; b < 6; ++b)
#pragma unroll
        for (int j = 0; j < 4; ++j) { float s = acc[b][j]; s += __shfl_xor(s, 16); s += __shfl_xor(s, 32); acc[b][j] = s; }
}
__device__ __forceinline__ void p0_rows_fwd(Frame& F);
__device__ __forceinline__ void p0a(Frame& F) {
    const int tid = F.tid, lane = F.lane, wave = F.wave;
    {
        LAS float* sc = (LAS float*)(F.lds);
        LAS float* red = sc + 6144;
        for (int i = tid; i < 6144; i += NWAVES * 64) { const int b = i >> 10, k = i & 1023; const float v = b < 2 ? F.in[I_CP][b * 1024 + k] : F.in[I_CS][(b - 2) * 1024 + k]; sc[i] = v * sigmoidf_fast(v); }
        __syncthreads();
        float* MOD = (float*)(F.ws + WS_MOD);
        for (int item = F.vcu; item < 192; item += F.G) {
            const int l = item / 96, n0 = (item % 96) * 64;
            f32x4 acc[6];
            gemv6_wave(F.in[I_WMOD] + (size_t)l * 1024 * 6144 + n0, 6144, sc, wave * 128, lane, acc);
            if (lane < 16) {
#pragma unroll
                for (int b = 0; b < 6; ++b) *(LAS f32x4*)(red + (wave * 6 + b) * 64 + 4 * lane) = acc[b]; }
            __syncthreads();
            if (tid < 384) { const int b = tid >> 6, ln = tid & 63; float s = 0.f;
#pragma unroll
                for (int w = 0; w < 8; ++w) s += red[(w * 6 + b) * 64 + ln];
                MOD[((size_t)l * 6 + b) * 6144 + n0 + ln] = s + F.in[I_BMOD][l * 6144 + n0 + ln]; }
            __syncthreads();
        }
    }
    PSTAMP(60);
    {
        LAS float* scr = (LAS float*)(F.lds + wave * 16640);
        const int gw = F.vcu * NWAVES + wave, NGW = F.G * NWAVES;
        constexpr int I_IN = 16 * 24, I_OUT = 16 * 16, I_F1 = 16 * 64, I_F2 = 64 * 16, PER_L = I_IN + I_OUT + I_F1 + I_F2;
        for (int it = gw; it < 2 * PER_L; it += NGW) {
            const int l = it / PER_L; int r = it % PER_L;
            if (r < I_IN) { if (l == 1) p0_transpose_item(F.in[I_WIN] + (size_t)l * 1024 * 1536, 1536, 1536, (bf16*)(F.ws + WS_WIN) + (size_t)l * 1536 * 1024, 1024, 0, 0, scr, r, lane); continue; } r -= I_IN;
            if (r < I_OUT) { p0_transpose_item(F.in[I_WOUT] + (size_t)l * 1024 * 1024, 1024, 1024, (bf16*)(F.ws + WS_WEFF) + (size_t)l * 1024 * 1024, 1024, 0, 0, scr, r, lane); continue; } r -= I_OUT;
            if (r < I_F1) { p0_transpose_item(F.in[I_WFF1] + (size_t)l * 1024 * 4096, 4096, 4096, (bf16*)(F.ws + WS_WFF1) + (size_t)l * 4096 * 1024, 1024, 0, 0, scr, r, lane); continue; } r -= I_F1;
            p0_transpose_item(F.in[I_WFF2] + (size_t)l * 4096 * 1024, 1024, 1024, (bf16*)(F.ws + WS_WFF2) + (size_t)l * 1024 * 4096, 4096, 0, 0, scr, r, lane);
        }
    }
    PSTAMP(61);
    {
        const int gt0 = F.vcu * (NWAVES * 64) + tid, GT = F.G * NWAVES * 64;
#define TAB_GT(first_wg) ((gt0 + GT - (first_wg) * (NWAVES * 64)) % GT)
        int gt = TAB_GT(0);
        bf16* T1 = (bf16*)(F.ws + WS_T1);
        for (int i = gt; i < 96 * 64; i += GT) { const int row = i >> 6, s1 = i & 63, k1 = row % 48, m = (k1 * s1) & 63; const float x = (float)m * (1.0f / 32.0f);
            T1[i] = (bf16)f2bf(row < 48 ? cospif(x) : -sinpif(x)); }
        bf16* T2 = (bf16*)(F.ws + WS_T2);
        gt = TAB_GT(16);
        for (int i = gt; i < 128 * 128; i += GT) { const int k2 = i >> 7, s2 = i & 127, m = (k2 * s2) & 127; const float x = (float)m * (1.0f / 64.0f);
            T2[i] = (bf16)f2bf(cospif(x)); T2[128 * 128 + i] = (bf16)f2bf(sinpif(x)); }
        f32x2* TW = (f32x2*)(F.ws + WS_TW);
        gt = TAB_GT(48);
        for (int i = gt; i < 128 * 64; i += GT) { const int s2 = i >> 6, k1 = i & 63, m = k1 * s2; const float x = (float)m * (1.0f / 4096.0f), sc = 0.011048543456039806f;
            TW[i] = (f32x2){cospif(x) * sc, sinpif(x) * sc}; }
        gt = TAB_GT(64);
        for (int i = gt; i < 64 * 64; i += GT) { const int s2 = i >> 6, k1 = i & 63, m = k1 * s2; const float x = (float)m * (1.0f / 2048.0f), sc = 0.015625f;
            TW[128 * 64 + i] = (f32x2){cospif(x) * sc, sinpif(x) * sc}; }
        bf16* WCT = (bf16*)(F.ws + WS_WCT);
        LAS float* cst = (LAS float*)(F.lds + 140000);
        if (tid < 64) { const float x = (float)tid * (1.0f / 32.0f); cst[tid] = cospif(x); cst[64 + tid] = sinpif(x); }
        __syncthreads();
        gt = TAB_GT(72);
        for (int i = gt; i < 2 * 8 * 2 * 4096; i += GT) { const int e = i & 63, d = (i >> 6) & 63, ty = (i >> 12) & 1, lh = i >> 13;
            const float* wf = F.in[I_WF] + (size_t)lh * 4096 + e; float s = 0.f;
#pragma unroll 1
            for (int m0 = 0; m0 < 64; m0 += 16) { float wv[16];
#pragma unroll
                for (int m = 0; m < 16; ++m) wv[m] = wf[(m0 + m) * 64];
#pragma unroll
                for (int m = 0; m < 16; ++m) { const int j = ((m0 + m) * d) & 63; s += (ty ? -cst[64 + j] : cst[j]) * wv[m]; } }
            WCT[((size_t)lh * 64 + e) * 128 + ty * 64 + d] = (bf16)f2bf(s * 0.125f); }
        bf16* WG = (bf16*)(F.ws + WS_WG);
        gt = TAB_GT(200);
        for (int i = gt; i < 2 * 8 * 320 * 64; i += GT) { const int k = i & 63, n = (i >> 6) % 320, lh = (i >> 6) / 320, l = lh >> 3, h = lh & 7; float v;
            if (n < 256) { const int g = n >> 6, e = n & 63, dir = g >> 1; const float* src = (g & 1) ? F.in[I_WIG] : F.in[I_WRG]; v = -1.44269504089f * src[((size_t)((l * 2 + dir) * 8 + h) * 64 + k) * 64 + e]; }
            else v = (k == n - 256) ? 1.0f : 0.0f;
            WG[i] = (bf16)f2bf(v); }
        float* CL = (float*)(F.ws + WS_CL);
        gt = TAB_GT(68);
        for (int i = gt; i < 2 * 2 * 512; i += GT) { const float lam = F.in[I_LAM][i]; CL[i] = -8.0f * log1pf(expf(-lam)) * 1.44269504089f; }
#undef TAB_GT
    }
    p0_rows_fwd(F);
}

__device__ __forceinline__ void p0_rows_fwd(Frame& F) {
    const int lane = F.lane, wave = F.wave;
    const int gw = F.vcu * NWAVES + wave, NGW = F.G * NWAVES;
    bf16* A = (bf16*)(F.ws + WS_A); float* SS = (float*)(F.ws + WS_SS);
    for (int row0 = gw * 4; row0 < MTOK; row0 += NGW * 4) {
        f32x4 v[4][4];
#pragma unroll
        for (int rr = 0; rr < 4; ++rr) { const int row = row0 + rr; const float* xr = row < 16384 ? F.in[I_XP] + (size_t)row * 1024 : F.in[I_XS] + (size_t)(row - 16384) * 1024;
#pragma unroll
            for (int j = 0; j < 4; ++j) v[rr][j] = *(const GAS f32x4*)(xr + 4 * lane + 256 * j); }
#pragma unroll
        for (int rr = 0; rr < 4; ++rr) { const int row = row0 + rr; float s = 0.f;
#pragma unroll
            for (int j = 0; j < 4; ++j) s += (v[rr][j][0] * v[rr][j][0] + v[rr][j][1] * v[rr][j][1]) + (v[rr][j][2] * v[rr][j][2] + v[rr][j][3] * v[rr][j][3]);
            s = wave_sum(s);
#pragma unroll
            for (int j = 0; j < 4; ++j) { v2u o; o.x = pk2(v[rr][j][0], v[rr][j][1]); o.y = pk2(v[rr][j][2], v[rr][j][3]);
                *(GAS v2u*)(A + (size_t)row * 1024 + 4 * lane + 256 * j) = o; }
            if (lane < 16) SS[(size_t)row * 16 + lane] = lane == 0 ? s : 0.f; }
    }
}

__device__ __forceinline__ void p0b(Frame& F) {
    const int tid = F.tid, lane = F.lane, wave = F.wave;
    const float* MOD = (const float*)(F.ws + WS_MOD);
    {
        LAS float* sh = (LAS float*)(F.lds + 65536);
        LAS float* red = sh + 6144;
        for (int item = F.vcu; item < 176; item += F.G) {
            const int l = item / 88, r = item % 88; const bool is1 = r < 24; const int n0 = (is1 ? r : r - 24) * 64, ldn = is1 ? 1536 : 4096, kind = is1 ? 0 : 3;
            __syncthreads();
            for (int i = tid; i < 6144; i += NWAVES * 64) { const int b = i >> 10, k = i & 1023; sh[i] = MOD[((size_t)l * 6 + b) * 6144 + kind * 1024 + k]; }
            __syncthreads();
            f32x4 acc[6];
            gemv6_wave((is1 ? F.in[I_WIN] + (size_t)l * 1024 * 1536 : F.in[I_WFF1] + (size_t)l * 1024 * 4096) + n0, ldn, sh, wave * 128, lane, acc);
            if (lane < 16) {
#pragma unroll
                for (int b = 0; b < 6; ++b) *(LAS f32x4*)(red + (wave * 6 + b) * 64 + 4 * lane) = acc[b]; }
            __syncthreads();
            if (tid < 384) { const int b = tid >> 6, ln = tid & 63; float s = 0.f;
#pragma unroll
                for (int w = 0; w < 8; ++w) s += red[(w * 6 + b) * 64 + ln];
                float* dst = is1 ? (float*)(F.ws + WS_BIAS1) + ((size_t)l * 6 + b) * 1536 : (float*)(F.ws + WS_BIAS2) + ((size_t)l * 6 + b) * 4096;
                dst[n0 + ln] = s; }
        }
        __syncthreads();
    }
    PSTAMP(63);
    {
        const int gt = F.vcu * (NWAVES * 64) + tid, GT = F.G * NWAVES * 64;
        float* VEC = (float*)(F.ws + WS_VEC);
        for (int i = gt; i < 2 * 6 * 4 * 1024; i += GT) { const int k = i & 1023, kind = (i >> 10) & 3, lb = i >> 12, l = lb / 6; const float* m = MOD + (size_t)lb * 6144; float v;
            if (kind == 0) v = F.in[I_GMIX][l * 1024 + k] * (1.0f + m[1024 + k]);
            else if (kind == 1) v = m[2048 + k];
            else if (kind == 2) v = F.in[I_GMLP][l * 1024 + k] * (1.0f + m[4096 + k]);
            else v = m[5120 + k];
            VEC[i] = v; }
    }
    PSTAMP(64);
    {
        __syncthreads();
        LAS float* scr = (LAS float*)(F.lds + wave * 16640);
        const int gw = ((F.vcu + F.G - 176 % F.G) % F.G) * NWAVES + wave, NGW = F.G * NWAVES;
        for (int it = gw; it < 16 * 24; it += NGW) p0_transpose_item_scaled(F.in[I_WIN], F.in[I_GMIX], MOD, (bf16*)(F.ws + WS_WIN0), scr, it, lane);
    }
}

__device__ __forceinline__ void final_norm(Frame& F) {
    const int gw = F.vcu * NWAVES + F.wave, NGW = F.G * NWAVES, lane = F.lane;
    const float* SS = (const float*)(F.ws + WS_SS);
    f32x4 g[4];
#pragma unroll
    for (int j = 0; j < 4; ++j) g[j] = *(const f32x4*)(F.in[I_GFIN] + 4 * lane + 256 * j);
    const bf16* X2 = (const bf16*)(F.ws + WS_A);
    for (int row0 = gw * 4; row0 < MTOK; row0 += NGW * 4) {
        v2u v[4][4]; float r[4];
#pragma unroll
        for (int rr = 0; rr < 4; ++rr) { r[rr] = pg8::row_rscale(SS, row0 + rr);
#pragma unroll
            for (int j = 0; j < 4; ++j) v[rr][j] = *(const GAS v2u*)(X2 + (size_t)(row0 + rr) * 1024 + 4 * lane + 256 * j); }
#pragma unroll
        for (int rr = 0; rr < 4; ++rr) { float* xr = F.out + (size_t)(row0 + rr) * 1024;
#pragma unroll
            for (int j = 0; j < 4; ++j) { const f32x4 x = (f32x4){bflo(v[rr][j].x), bfhi(v[rr][j].x), bflo(v[rr][j].y), bfhi(v[rr][j].y)};
                *(GAS f32x4*)(xr + 4 * lane + 256 * j) = x * r[rr] * g[j]; } }
    }
}
__device__ __forceinline__ void load_wg_tables(Frame& F, int l, int h, int t0 = -1, int nthr = NWAVES * 64) {
    if (t0 < 0) t0 = F.tid;
    const bf16* WG = (const bf16*)(F.ws + WS_WG) + (size_t)(l * 8 + h) * 320 * 64;
    for (int i = t0; i < 320 * 8; i += nthr) { const int n = i >> 3, c = i & 7; *(LAS v4u*)(F.lds + L_WG + n * 144 + c * 16) = *(const GAS v4u*)(WG + n * 64 + c * 8); }
    LAS float* par = (LAS float*)(F.lds + L_PAR);
    for (int i = t0; i < 11 * 64; i += nthr) { const int p = i >> 6, c = i & 63, ch = h * 64 + c; float v;
        if (p < 4) v = F.in[I_CONVW][(size_t)l * 4 * 512 + p * 512 + ch];
        else if (p == 4) v = F.in[I_CONVB][l * 512 + ch];
        else if (p == 5) v = -1.44269504089f * F.in[I_BRG][(l * 2 + 0) * 512 + ch];
        else if (p == 6) v = -1.44269504089f * F.in[I_BIG][(l * 2 + 0) * 512 + ch];
        else if (p == 7) v = -1.44269504089f * F.in[I_BRG][(l * 2 + 1) * 512 + ch];
        else if (p == 8) v = -1.44269504089f * F.in[I_BIG][(l * 2 + 1) * 512 + ch];
        else if (p == 9) v = ((const float*)(F.ws + WS_CL))[(l * 2 + 0) * 512 + ch];
        else v = ((const float*)(F.ws + WS_CL))[(l * 2 + 1) * 512 + ch];
        par[i] = v; }
}
__device__ __forceinline__ void load_t1(Frame& F) {
    const bf16* T1 = (const bf16*)(F.ws + WS_T1);
    for (int i = F.tid; i < 96 * 8; i += NWAVES * 64) { const int r = i >> 3, c = i & 7; *(LAS v4u*)(F.lds + L_T1 + r * 144 + c * 16) = *(const GAS v4u*)(T1 + r * 64 + c * 8); }
}
__device__ __forceinline__ void load_t2(Frame& F) {
    const bf16* T2 = (const bf16*)(F.ws + WS_T2);
    for (int i = F.tid; i < 2 * 128 * 16; i += NWAVES * 64) { const int t = i >> 11, r = (i >> 4) & 127, c = i & 15; *(LAS v4u*)(F.lds + (t ? L_T2S : L_T2) + r * 272 + c * 16) = *(const GAS v4u*)(T2 + (size_t)t * 16384 + r * 128 + c * 8); }
}

__device__ __forceinline__ f32x2 exp2_2(f32x2 v) { f32x2 r; r.x = __builtin_amdgcn_exp2f(v.x); r.y = __builtin_amdgcn_exp2f(v.y); return r; }
__device__ __forceinline__ f32x2 rcp_2(f32x2 v) { f32x2 r; r.x = __builtin_amdgcn_rcpf(v.x); r.y = __builtin_amdgcn_rcpf(v.y); return r; }
__device__ __forceinline__ f32x2 sqrt_2(f32x2 v) { f32x2 r; r.x = __builtin_amdgcn_sqrtf(v.x); r.y = __builtin_amdgcn_sqrtf(v.y); return r; }
constexpr size_t WS_AGGB = WS_AGG;
constexpr size_t WS_AGGW = WS_AGG + 4 * MiB;
constexpr size_t WS_S0 = WS_A, WS_S1 = WS_A + 32 * MiB, WS_S2 = 288 * MiB;
constexpr size_t WS_AGGBF = 10 * MiB;
constexpr int L_ST = 49152;
static_assert(L_ST + 8 * 7680 <= MISC_OFF, "S half-tiles");
template <int MODE>
__device__ __forceinline__ void lru_block(Frame& F, int lane, int b, int h, int tb0, const float (&cf)[2], const float (&cb)[2], f32x2 (&agf)[2], f32x2 (&agb)[2]) {
    constexpr bool FINAL = (MODE != 0);
    const int w = F.wave, q = lane & 31, hh = lane >> 5;
    const int tokS = seq_tok0(b), S = seq_len(b);
    const LAS unsigned char* Wg = F.lds + L_WG; const LAS float* par = (const LAS float*)(F.lds + L_PAR);
    const bf16* Z = (const bf16*)(F.ws + WS_Z);
    bf16x8 Af[4], Ag[4];
    {
        const int t = tb0 + q;
        v4u raw[4][4];
#pragma unroll
        for (int kk = 0; kk < 4; ++kk) {
            const int tt = t - 2 + kk;
            const int ttc = tt < tokS ? tokS : (tt >= tokS + S ? tokS + S - 1 : tt);
            const bf16* rp = Z + (size_t)ttc * DIN + 512 + h * 64 + 8 * hh;
#pragma unroll
            for (int ks = 0; ks < 4; ++ks) raw[kk][ks] = *(const GAS v4u*)(rp + 16 * ks);
        }
        if (FINAL) {
#pragma unroll
            for (int ks = 0; ks < 4; ++ks) Ag[ks] = __builtin_bit_cast(bf16x8, *(const GAS v4u*)(Z + (size_t)t * DIN + 1024 + h * 64 + 16 * ks + 8 * hh));
        }
        __builtin_amdgcn_sched_barrier(0);
        if (tb0 - 2 < tokS || tb0 + 33 > tokS + S) {
#pragma unroll
            for (int kk = 0; kk < 4; ++kk) { const int tt = t - 2 + kk; const bool valid = (tt >= tokS) && (tt < tokS + S);
                if (!valid) {
#pragma unroll
                    for (int ks = 0; ks < 4; ++ks) raw[kk][ks] = (v4u){0u, 0u, 0u, 0u}; } } }
#pragma unroll
        for (int ks = 0; ks < 4; ++ks) {
            const int c0 = 16 * ks + 8 * hh;
            f32x2 a8[4];
            { const f32x4 b0 = *(const LAS f32x4*)(par + 4 * 64 + c0), b1 = *(const LAS f32x4*)(par + 4 * 64 + c0 + 4);
              a8[0] = (f32x2){b0[0], b0[1]}; a8[1] = (f32x2){b0[2], b0[3]}; a8[2] = (f32x2){b1[0], b1[1]}; a8[3] = (f32x2){b1[2], b1[3]}; }
#pragma unroll
            for (int kk = 0; kk < 4; ++kk) {
                const v4u rw = raw[kk][ks];
                const f32x4 w0 = *(const LAS f32x4*)(par + kk * 64 + c0), w1 = *(const LAS f32x4*)(par + kk * 64 + c0 + 4);
                a8[0] += (f32x2){bflo(rw.x), bfhi(rw.x)} * (f32x2){w0[0], w0[1]}; a8[1] += (f32x2){bflo(rw.y), bfhi(rw.y)} * (f32x2){w0[2], w0[3]};
                a8[2] += (f32x2){bflo(rw.z), bfhi(rw.z)} * (f32x2){w1[0], w1[1]}; a8[3] += (f32x2){bflo(rw.w), bfhi(rw.w)} * (f32x2){w1[2], w1[3]};
            }
            v4u pk; pk.x = pk2(a8[0].x, a8[0].y); pk.y = pk2(a8[1].x, a8[1].y); pk.z = pk2(a8[2].x, a8[2].y); pk.w = pk2(a8[3].x, a8[3].y);
            Af[ks] = __builtin_bit_cast(bf16x8, pk);
        }
    }
#pragma unroll
    for (int e2 = 0; e2 < 2; ++e2) {
        f32x16 acc[5], aug;
#pragma unroll
        for (int g = 0; g < 5; ++g)
#pragma unroll
            for (int i = 0; i < 16; ++i) acc[g][i] = 0.f;
#pragma unroll
        for (int i = 0; i < 16; ++i) aug[i] = 0.f;
#pragma unroll
        for (int ks = 0; ks < 4; ++ks)
#pragma unroll
            for (int g = 0; g < 5; ++g) { const int n = (g < 4 ? g * 64 : 256) + e2 * 32 + q;
                const bf16x8 Bf = *(const LAS bf16x8*)(Wg + n * 144 + (16 * ks + 8 * hh) * 2);
                acc[g] = __builtin_amdgcn_mfma_f32_32x32x16_bf16(Af[ks], Bf, acc[g], 0, 0, 0);
                if (FINAL && g == 4) aug = __builtin_amdgcn_mfma_f32_32x32x16_bf16(Ag[ks], Bf, aug, 0, 0, 0); }
        const int c = e2 * 32 + q;
        const float brf = par[5 * 64 + c], bif = par[6 * 64 + c], brb = par[7 * 64 + c], bib = par[8 * 64 + c], clf = par[9 * 64 + c], clb = par[10 * 64 + c];
#pragma unroll
        for (int i = 0; i < 16; i += 2) {
            const f32x2 uc = (f32x2){acc[4][i], acc[4][i + 1]};
            const f32x2 rf = rcp_2(exp2_2((f32x2){acc[0][i], acc[0][i + 1]} + brf) + 1.0f), gi = rcp_2(exp2_2((f32x2){acc[1][i], acc[1][i + 1]} + bif) + 1.0f);
            const f32x2 af = exp2_2(rf * clf);
            const f32x2 bxf = sqrt_2(1.0f - af * af) * (gi * uc);
            acc[0][i] = af.x; acc[0][i + 1] = af.y; acc[1][i] = bxf.x; acc[1][i + 1] = bxf.y;
            const f32x2 rb = rcp_2(exp2_2((f32x2){acc[2][i], acc[2][i + 1]} + brb) + 1.0f), gib = rcp_2(exp2_2((f32x2){acc[3][i], acc[3][i + 1]} + bib) + 1.0f);
            const f32x2 ab = exp2_2(rb * clb);
            const f32x2 bxb = sqrt_2(1.0f - ab * ab) * (gib * uc);
            acc[2][i] = ab.x; acc[2][i + 1] = ab.y; acc[3][i] = bxb.x; acc[3][i + 1] = bxb.y;
        }
        float Pg[4], Hg[4], oP[4], oH[4];
#pragma unroll
        for (int g = 0; g < 4; ++g) { float hs = 0.f, p = 1.f;
#pragma unroll
            for (int r = 0; r < 4; ++r) { const int i = 4 * g + r; hs = acc[0][i] * hs + acc[1][i]; p *= acc[0][i]; acc[1][i] = hs; acc[0][i] = p; }
            Pg[g] = p; Hg[g] = hs; oP[g] = __shfl_xor(p, 32); oH[g] = __shfl_xor(hs, 32); }
        float cg0f[4], ppf[4];
        { float cc = 0.f, pp = 1.f;
#pragma unroll
            for (int g = 0; g < 4; ++g) { const float Pl = hh ? oP[g] : Pg[g], Hl = hh ? oH[g] : Hg[g], Ph = hh ? Pg[g] : oP[g], Hh = hh ? Hg[g] : oH[g];
                const float c_lo = cc, p_lo = pp; cc = Pl * cc + Hl; pp *= Pl;
                const float c_hi = cc, p_hi = pp; cc = Ph * cc + Hh; pp *= Ph;
                cg0f[g] = hh ? c_hi : c_lo; ppf[g] = hh ? p_hi : p_lo; }
            agf[e2] = (f32x2){pp, cc}; }
#pragma unroll
        for (int g = 0; g < 4; ++g) { float hs = 0.f, p = 1.f;
#pragma unroll
            for (int r = 3; r >= 0; --r) { const int i = 4 * g + r; hs = acc[2][i] * hs + acc[3][i]; p *= acc[2][i]; acc[3][i] = hs; acc[2][i] = p; }
            Pg[g] = p; Hg[g] = hs; oP[g] = __shfl_xor(p, 32); oH[g] = __shfl_xor(hs, 32); }
        float cg0b[4], ppb[4];
        { float cc = 0.f, pp = 1.f;
#pragma unroll
            for (int g = 3; g >= 0; --g) { const float Pl = hh ? oP[g] : Pg[g], Hl = hh ? oH[g] : Hg[g], Ph = hh ? Pg[g] : oP[g], Hh = hh ? Hg[g] : oH[g];
                const float c_hi = cc, p_hi = pp; cc = Ph * cc + Hh; pp *= Ph;
                const float c_lo = cc, p_lo = pp; cc = Pl * cc + Hl; pp *= Pl;
                cg0b[g] = hh ? c_hi : c_lo; ppb[g] = hh ? p_hi : p_lo; }
            agb[e2] = (f32x2){pp, cc}; }
        if (MODE == 2) {
            LAS bf16* st = (LAS bf16*)(F.lds + L_ST + w * 7680) + q;
#pragma unroll
            for (int g = 0; g < 4; ++g) {
#pragma unroll
                for (int r = 0; r < 4; r += 2) { const int i = 4 * g + r, tok = r + 8 * g + 4 * hh;
                    const f32x2 pf = (f32x2){acc[0][i], acc[0][i + 1]}, pb = (f32x2){acc[2][i], acc[2][i + 1]};
                    const f32x2 hf = (f32x2){acc[1][i], acc[1][i + 1]} + pf * cg0f[g], hb = (f32x2){acc[3][i], acc[3][i + 1]} + pb * cg0b[g];
                    const f32x2 x = (f32x2){aug[i], aug[i + 1]};
                    const f32x2 y2 = (x + (x * x) * x * 0.044715f) * (-2.3022081981f);
                    const f32x2 ge = x * rcp_2(exp2_2(y2) + 1.0f);
                    const f32x2 s0 = (hf + hb) * ge, s1 = pf * ppf[g] * ge, s2 = pb * ppb[g] * ge;
                    const unsigned w0 = pk2(s0.x, s0.y), w1 = pk2(s1.x, s1.y), w2 = pk2(s2.x, s2.y);
                    st[tok * 40] = (bf16)(w0 & 0xffffu); st[(tok + 1) * 40] = (bf16)(w0 >> 16);
                    st[1280 + tok * 40] = (bf16)(w1 & 0xffffu); st[1280 + (tok + 1) * 40] = (bf16)(w1 >> 16);
                    st[2560 + tok * 40] = (bf16)(w2 & 0xffffu); st[2560 + (tok + 1) * 40] = (bf16)(w2 >> 16); }
            }
            LDS_WAIT(); asm volatile("" ::: "memory");
            const LAS unsigned char* sr = F.lds + L_ST + w * 7680 + q * 80 + hh * 32;
            v4u sv[3][2];
#pragma unroll
            for (int j = 0; j < 3; ++j) { sv[j][0] = *(const LAS v4u*)(sr + j * 2560); sv[j][1] = *(const LAS v4u*)(sr + j * 2560 + 16); }
            LDS_WAIT(); asm volatile("" ::: "memory");
            const size_t so = (size_t)(tb0 + q) * 512 + h * 64 + e2 * 32 + hh * 16;
            *(GAS v4u*)((bf16*)(F.ws + WS_S0) + so) = sv[0][0]; *(GAS v4u*)((bf16*)(F.ws + WS_S0) + so + 8) = sv[0][1];
            *(GAS v4u*)((bf16*)(F.ws + WS_S1) + so) = sv[1][0]; *(GAS v4u*)((bf16*)(F.ws + WS_S1) + so + 8) = sv[1][1];
            *(GAS v4u*)((bf16*)(F.ws + WS_S2) + so) = sv[2][0]; *(GAS v4u*)((bf16*)(F.ws + WS_S2) + so + 8) = sv[2][1];
        }
        if (MODE == 1) {
            LAS bf16* yt = (LAS bf16*)(F.lds + L_YT + w * 4608) + c;
#pragma unroll
            for (int g = 0; g < 4; ++g) {
                const float carf = cg0f[g] + ppf[g] * cf[e2], carb = cg0b[g] + ppb[g] * cb[e2];
#pragma unroll
                for (int r = 0; r < 4; r += 2) { const int i = 4 * g + r, tok = r + 8 * g + 4 * hh;
                    const f32x2 hf = (f32x2){acc[1][i], acc[1][i + 1]} + (f32x2){acc[0][i], acc[0][i + 1]} * carf, hb = (f32x2){acc[3][i], acc[3][i + 1]} + (f32x2){acc[2][i], acc[2][i + 1]} * carb;
                    const f32x2 x = (f32x2){aug[i], aug[i + 1]};
                    const f32x2 y2 = (x + (x * x) * x * 0.044715f) * (-2.3022081981f);
                    const f32x2 ge = x * rcp_2(exp2_2(y2) + 1.0f);
                    const f32x2 y = (hf + hb) * ge;
                    const unsigned wy = pk2(y.x, y.y); yt[tok * 72] = (bf16)(wy & 0xffffu); yt[(tok + 1) * 72] = (bf16)(wy >> 16); }
            }
        }
    }
    if (MODE == 1) {
        LDS_WAIT(); asm volatile("" ::: "memory");
        const LAS unsigned char* yr = F.lds + L_YT + w * 4608 + q * 144 + hh * 64;
        bf16* yo = (bf16*)(F.ws + WS_A2) + (size_t)(tb0 + q) * 1024 + 512 + h * 64 + hh * 32;
        v4u yv[4];
#pragma unroll
        for (int j = 0; j < 4; ++j) yv[j] = *(const LAS v4u*)(yr + 16 * j);
        LDS_WAIT(); asm volatile("" ::: "memory");
#pragma unroll
        for (int j = 0; j < 4; ++j) *(GAS v4u*)(yo + 8 * j) = yv[j];
    }
}
template <int MODE>
__device__ __forceinline__ void lru_phase(Frame& F, int l, bool pre = false) {
    constexpr bool FINAL = (MODE == 1);
#pragma unroll 1
    for (int v = F.vcu; v < 256; v += F.G) {
        const int h = v >> 5, rg = v & 31, tok = rg * 1024, b = pg8::seq_of_row(tok), tokS = seq_tok0(b), nrg = seq_len(b) >> 7, r0 = (tok - tokS) >> 7;
        { int t_ = F.tid; asm volatile("" : "+v"(t_)); F.tid = t_; F.lane = t_ & 63; }
        __syncthreads();
        if (!(pre && v == F.vcu)) load_wg_tables(F, l, h);
        float* AGGB = (float*)(F.ws + WS_AGGB); float* AGGW = (float*)(F.ws + WS_AGGW) + (size_t)(b * 8 + h) * 64 * 256;
        if (FINAL) {
            for (int i = F.tid; i < nrg * 64; i += NWAVES * 64) *(LAS v4u*)(F.lds + L_STREAM + i * 16) = *(const GAS v4u*)(AGGW + i * 4);
            __syncthreads();
            if (F.tid < 128) { const int dir = F.tid >> 6, c = F.tid & 63; LAS float* cu = (LAS float*)(F.lds + L_CU); const LAS float* st = (const LAS float*)(F.lds + L_STREAM);
                float cc = 0.f;
                if (dir == 0) { for (int j = 0; j < r0 + 8; ++j) { if (j >= r0) cu[((j - r0) * 2 + 0) * 64 + c] = cc; const f32x2 a = *(const LAS f32x2*)(st + ((j * 2 + 0) * 64 + c) * 2); cc = a.x * cc + a.y; } }
                else { for (int j = nrg - 1; j >= r0; --j) { if (j < r0 + 8) cu[((j - r0) * 2 + 1) * 64 + c] = cc; const f32x2 a = *(const LAS f32x2*)(st + ((j * 2 + 1) * 64 + c) * 2); cc = a.x * cc + a.y; } }
            }
        }
        __syncthreads();
        int lane = F.lane; asm volatile("" : "+v"(lane));
        const int w = F.wave, q = lane & 31, hh = lane >> 5;
        const int tw0 = tok + 128 * w, blk0 = tw0 >> 5;
        float cf[2] = {0.f, 0.f}, cbk[4][2];
#pragma unroll
        for (int k = 0; k < 4; ++k) { cbk[k][0] = 0.f; cbk[k][1] = 0.f; }
        if (FINAL) {
            const LAS float* cu = (const LAS float*)(F.lds + L_CU);
#pragma unroll
            for (int e2 = 0; e2 < 2; ++e2) { const int c = e2 * 32 + q;
                cf[e2] = cu[(w * 2 + 0) * 64 + c];
                float cc = cu[(w * 2 + 1) * 64 + c]; cbk[3][e2] = cc;
#pragma unroll
                for (int k = 3; k >= 1; --k) { const f32x2 a = *(const f32x2*)(AGGB + ((size_t)((blk0 + k) * 8 + h) * 64 + c) * 2); cc = a.x * cc + a.y; cbk[k - 1][e2] = cc; } }
        }
        f32x2 wf[2] = {(f32x2){1.f, 0.f}, (f32x2){1.f, 0.f}}, wb[2] = {(f32x2){1.f, 0.f}, (f32x2){1.f, 0.f}};
#pragma unroll 1
        for (int k = 0; k < 4; ++k) {
            f32x2 agf[2], agb[2];
            const float cbv[2] = {k == 0 ? cbk[0][0] : (k == 1 ? cbk[1][0] : (k == 2 ? cbk[2][0] : cbk[3][0])), k == 0 ? cbk[0][1] : (k == 1 ? cbk[1][1] : (k == 2 ? cbk[2][1] : cbk[3][1]))};
            { int l2_ = lane; asm volatile("" : "+v"(l2_)); lane = l2_; }
            lru_block<MODE>(F, lane, b, h, tw0 + 32 * k, cf, cbv, agf, agb);
#ifdef LRU_DBG_SYNC
            if (!FINAL) { if (LRU_DBG_SYNC == 3) asm volatile("s_waitcnt vmcnt(0) lgkmcnt(0)" ::: "memory"); else __syncthreads(); }
#endif
#pragma unroll
            for (int e2 = 0; e2 < 2; ++e2) {
                if (FINAL) cf[e2] = agf[e2].x * cf[e2] + agf[e2].y;
                else { const int c = e2 * 32 + q;
                    if (hh == 0) { *(f32x2*)(AGGB + ((size_t)((blk0 + k) * 8 + h) * 64 + c) * 2) = agb[e2]; if (MODE == 2) *(f32x2*)((float*)(F.ws + WS_AGGBF) + ((size_t)((blk0 + k) * 8 + h) * 64 + c) * 2) = agf[e2]; }
                    wf[e2] = (f32x2){wf[e2].x * agf[e2].x, agf[e2].x * wf[e2].y + agf[e2].y};
                    wb[e2] = (f32x2){wb[e2].x * agb[e2].x, wb[e2].y + wb[e2].x * agb[e2].y}; }
            }
        }
        if (!FINAL && hh == 0) {
#pragma unroll
            for (int e2 = 0; e2 < 2; ++e2) { const int c = e2 * 32 + q;
                *(f32x2*)(AGGW + ((size_t)((r0 + w) * 2 + 0) * 64 + c) * 2) = wf[e2];
                *(f32x2*)(AGGW + ((size_t)((r0 + w) * 2 + 1) * 64 + c) * 2) = wb[e2]; }
        }
    }
}

constexpr int L_CARR = 61440;
__device__ __forceinline__ void lru_light_phase(Frame& F, int l) {
#pragma unroll 1
    for (int v = F.vcu; v < 256; v += F.G) {
        const int h = v >> 5, rg = v & 31, tok = rg * 1024, b = pg8::seq_of_row(tok), tokS = seq_tok0(b), nrg = seq_len(b) >> 7, r0 = (tok - tokS) >> 7;
        { int t_ = F.tid; asm volatile("" : "+v"(t_)); F.tid = t_; F.lane = t_ & 63; }
        __syncthreads();
        const float* AGGB = (const float*)(F.ws + WS_AGGB); const float* AGGF = (const float*)(F.ws + WS_AGGBF); const float* AGGW = (const float*)(F.ws + WS_AGGW) + (size_t)(b * 8 + h) * 64 * 256;
        for (int i = F.tid; i < nrg * 64; i += NWAVES * 64) *(LAS v4u*)(F.lds + L_STREAM + i * 16) = *(const GAS v4u*)(AGGW + i * 4);
        __syncthreads();
        if (F.tid < 128) { const int dir = F.tid >> 6, c = F.tid & 63; LAS float* cu = (LAS float*)(F.lds + L_CU); const LAS float* st = (const LAS float*)(F.lds + L_STREAM);
            float cc = 0.f;
            if (dir == 0) { for (int j = 0; j < r0 + 8; ++j) { if (j >= r0) cu[((j - r0) * 2 + 0) * 64 + c] = cc; const f32x2 a = *(const LAS f32x2*)(st + ((j * 2 + 0) * 64 + c) * 2); cc = a.x * cc + a.y; } }
            else { for (int j = nrg - 1; j >= r0; --j) { if (j < r0 + 8) cu[((j - r0) * 2 + 1) * 64 + c] = cc; const f32x2 a = *(const LAS f32x2*)(st + ((j * 2 + 1) * 64 + c) * 2); cc = a.x * cc + a.y; } }
        }
        __syncthreads();
        int lane = F.lane; asm volatile("" : "+v"(lane));
        const int w = F.wave, tw0 = tok + 128 * w, blk0 = tw0 >> 5;
        LAS float* carr = (LAS float*)(F.lds + L_CARR + w * 2048);
        { const LAS float* cu = (const LAS float*)(F.lds + L_CU); const int c = lane;
            float cc = cu[(w * 2 + 0) * 64 + c];
#pragma unroll
            for (int k = 0; k < 4; ++k) { carr[(k * 2 + 0) * 64 + c] = cc; const f32x2 a = *(const f32x2*)(AGGF + ((size_t)((blk0 + k) * 8 + h) * 64 + c) * 2); cc = a.x * cc + a.y; }
            cc = cu[(w * 2 + 1) * 64 + c];
#pragma unroll
            for (int k = 3; k >= 0; --k) { carr[(k * 2 + 1) * 64 + c] = cc; const f32x2 a = *(const f32x2*)(AGGB + ((size_t)((blk0 + k) * 8 + h) * 64 + c) * 2); cc = a.x * cc + a.y; }
        }
        LDS_WAIT(); asm volatile("" ::: "memory");
        const bf16* S0 = (const bf16*)(F.ws + WS_S0); const bf16* S1 = (const bf16*)(F.ws + WS_S1); const bf16* S2 = (const bf16*)(F.ws + WS_S2);
        bf16* A2 = (bf16*)(F.ws + WS_A2);
#pragma unroll 1
        for (int k = 0; k < 4; ++k) {
            v4u a0[4], a1[4], a2[4];
#pragma unroll
            for (int i = 0; i < 4; ++i) { const int id = lane + 64 * i, t = tw0 + 32 * k + (id >> 3), c8 = id & 7; const size_t o = (size_t)t * 512 + h * 64 + 8 * c8;
                a0[i] = *(const GAS v4u*)(S0 + o); a1[i] = *(const GAS v4u*)(S1 + o); a2[i] = *(const GAS v4u*)(S2 + o); }
            const int c8 = lane & 7;
            const f32x4 f0 = *(const LAS f32x4*)(carr + (k * 2 + 0) * 64 + 8 * c8), f1 = *(const LAS f32x4*)(carr + (k * 2 + 0) * 64 + 8 * c8 + 4);
            const f32x4 b0 = *(const LAS f32x4*)(carr + (k * 2 + 1) * 64 + 8 * c8), b1 = *(const LAS f32x4*)(carr + (k * 2 + 1) * 64 + 8 * c8 + 4);
#pragma unroll
            for (int i = 0; i < 4; ++i) { const int id = lane + 64 * i, t = tw0 + 32 * k + (id >> 3);
                v4u o;
                o.x = pk2(bflo(a0[i].x) + bflo(a1[i].x) * f0[0] + bflo(a2[i].x) * b0[0], bfhi(a0[i].x) + bfhi(a1[i].x) * f0[1] + bfhi(a2[i].x) * b0[1]);
                o.y = pk2(bflo(a0[i].y) + bflo(a1[i].y) * f0[2] + bflo(a2[i].y) * b0[2], bfhi(a0[i].y) + bfhi(a1[i].y) * f0[3] + bfhi(a2[i].y) * b0[3]);
                o.z = pk2(bflo(a0[i].z) + bflo(a1[i].z) * f1[0] + bflo(a2[i].z) * b1[0], bfhi(a0[i].z) + bfhi(a1[i].z) * f1[1] + bfhi(a2[i].z) * b1[1]);
                o.w = pk2(bflo(a0[i].w) + bflo(a1[i].w) * f1[2] + bflo(a2[i].w) * b1[2], bfhi(a0[i].w) + bfhi(a1[i].w) * f1[3] + bfhi(a2[i].w) * b1[3]);
                *(GAS v4u*)(A2 + (size_t)t * 1024 + 512 + h * 64 + 8 * c8) = o; }
        }
    }
}

__device__ __forceinline__ unsigned perm_lo(unsigned a, unsigned b) { return __builtin_amdgcn_perm(b, a, 0x05040100u); }
__device__ __forceinline__ unsigned perm_hi(unsigned a, unsigned b) { return __builtin_amdgcn_perm(b, a, 0x07060302u); }
__device__ __forceinline__ void make_bfrags(const v2u (&X)[8], bf16x8 (&Bf)[4]) {
#pragma unroll
    for (int jp = 0; jp < 4; ++jp) { v4u o;
        const unsigned a0 = (jp >> 1) ? X[0].y : X[0].x, a1 = (jp >> 1) ? X[1].y : X[1].x, a2 = (jp >> 1) ? X[2].y : X[2].x, a3 = (jp >> 1) ? X[3].y : X[3].x;
        const unsigned a4 = (jp >> 1) ? X[4].y : X[4].x, a5 = (jp >> 1) ? X[5].y : X[5].x, a6 = (jp >> 1) ? X[6].y : X[6].x, a7 = (jp >> 1) ? X[7].y : X[7].x;
        if (jp & 1) { o.x = perm_hi(a0, a1); o.y = perm_hi(a2, a3); o.z = perm_hi(a4, a5); o.w = perm_hi(a6, a7); }
        else { o.x = perm_lo(a0, a1); o.y = perm_lo(a2, a3); o.z = perm_lo(a4, a5); o.w = perm_lo(a6, a7); }
        Bf[jp] = __builtin_bit_cast(bf16x8, o); }
}
__device__ __forceinline__ void dft1_unit(Frame& F, int b, int s2, int cg) {
    int lane = F.lane; asm volatile("" : "+v"(lane));
    const int q = lane & 15, g = lane >> 4;
    const int tokS = seq_tok0(b), N2 = seq_len(b) >> 6;
    const bf16* Z = (const bf16*)(F.ws + WS_Z) + (size_t)(tokS + s2) * DIN + cg * 64 + 4 * q;
    pg8::f32x4 acc[6][4];
#pragma unroll
    for (int mt = 0; mt < 6; ++mt)
#pragma unroll
        for (int jp = 0; jp < 4; ++jp) acc[mt][jp] = (pg8::f32x4){0.f, 0.f, 0.f, 0.f};
    v2u X0[8], X1[8];
#pragma unroll
    for (int i = 0; i < 8; ++i) { X0[i] = *(const GAS v2u*)(Z + (size_t)(8 * g + i) * N2 * DIN); X1[i] = *(const GAS v2u*)(Z + (size_t)(32 + 8 * g + i) * N2 * DIN); }
    const f32x2* TW = (const f32x2*)(F.ws + WS_TW) + (N2 == 128 ? 0 : 128 * 64) + (size_t)s2 * 64;
    f32x4 tw[3][2];
#pragma unroll
    for (int mt = 0; mt < 3; ++mt) { tw[mt][0] = *(const GAS f32x4*)(TW + 16 * mt + 4 * g); tw[mt][1] = *(const GAS f32x4*)(TW + 16 * mt + 4 * g + 2); }
    __builtin_amdgcn_sched_barrier(0);
#pragma unroll
    for (int ks = 0; ks < 2; ++ks) {
        bf16x8 Bf[4]; if (ks == 0) make_bfrags(X0, Bf); else make_bfrags(X1, Bf);
#pragma unroll
        for (int mt = 0; mt < 6; ++mt) { const bf16x8 Afr = *(const LAS bf16x8*)(F.lds + L_T1 + (16 * mt + q) * 144 + (32 * ks + 8 * g) * 2);
#pragma unroll
            for (int jp = 0; jp < 4; ++jp) acc[mt][jp] = __builtin_amdgcn_mfma_f32_16x16x32_bf16(Afr, Bf[jp], acc[mt][jp], 0, 0, 0); }
    }
    bf16* Hb = (bf16*)(F.ws + WS_H) + (size_t)tokS * 1024 + cg * 64 + 4 * q;
#pragma unroll
    for (int mt = 0; mt < 3; ++mt)
#pragma unroll
        for (int r = 0; r < 4; ++r) { const int k1 = 16 * mt + 4 * g + r; const f32x2 t = (f32x2){tw[mt][r >> 1][2 * (r & 1)], tw[mt][r >> 1][2 * (r & 1) + 1]};
            if (k1 <= 32) {
                float hr[4], hi[4];
#pragma unroll
                for (int jp = 0; jp < 4; ++jp) { const float a = acc[mt][jp][r], bb = acc[mt + 3][jp][r]; hr[jp] = a * t.x + bb * t.y; hi[jp] = bb * t.x - a * t.y; }
                v2u o; o.x = pk2(hr[0], hr[1]); o.y = pk2(hr[2], hr[3]);
                *(GAS v2u*)(Hb + ((size_t)(k1 * 2 + 0) * N2 + s2) * 512) = o;
                o.x = pk2(hi[0], hi[1]); o.y = pk2(hi[2], hi[3]);
                *(GAS v2u*)(Hb + ((size_t)(k1 * 2 + 1) * N2 + s2) * 512) = o; } }
}
__device__ __forceinline__ void dft1_phase(Frame& F) {
    const int gw = F.vcu * NWAVES + F.wave, NGW = F.G * NWAVES;
#pragma unroll 1
    for (int id = gw; id < 4096; id += NGW) {
        int b, s2, cg;
        if (id < 2048) { b = id >> 10; const int rem = id & 1023; s2 = rem >> 3; cg = rem & 7; }
        else { const int i2 = id - 2048; b = 2 + (i2 >> 9); const int rem = i2 & 511; s2 = rem >> 3; cg = rem & 7; }
        dft1_unit(F, b, s2, cg);
    }
}
constexpr int A2P = 1024;
constexpr int L_XC = 0;
static_assert(L_XC + 8 * 8704 <= L_T2, "stage-B tiles below the T2 tables");
__device__ __forceinline__ void dft2_unit(Frame& F, int l, int b, int k1, int h, int kh) {
    int lane = F.lane; asm volatile("" : "+v"(lane));
    const int q = lane & 15, g = lane >> 4;
    const int tokS = seq_tok0(b), N2 = seq_len(b) >> 6, rs = 128 / N2;
    const bf16* Hb = (const bf16*)(F.ws + WS_H) + (size_t)tokS * 1024 + (size_t)k1 * 2 * N2 * 512 + h * 64 + 4 * q;
    pg8::f32x4 acc[8][4];
#pragma unroll
    for (int mt = 0; mt < 8; ++mt)
#pragma unroll
        for (int jp = 0; jp < 4; ++jp) acc[mt][jp] = (pg8::f32x4){0.f, 0.f, 0.f, 0.f};
    const int nks = (2 * N2) >> 5;
#define DFT2_LOAD(X, ks_) do { _Pragma("unroll") for (int i = 0; i < 8; ++i) X[i] = *(const GAS v2u*)(Hb + (size_t)(32 * (ks_) + 8 * g + i) * 512); } while (0)
#define DFT2_STEP(X, ks_) do { bf16x8 Bf[4]; make_bfrags(X, Bf); \
        const int kk0 = 32 * (ks_) + 8 * g, ri = kk0 >= N2 ? 1 : 0, s20 = kk0 - ri * N2; \
        _Pragma("unroll") for (int mt = 0; mt < 8; ++mt) { \
            const int ty = mt >> 2, k2 = 64 * kh + 16 * (mt & 3) + q; \
            const bool useC = (ty == ri), neg = (ty == 1) && (ri == 1); \
            v4u a = *(const LAS v4u*)(F.lds + (useC ? L_T2 : L_T2S) + (k2 * rs) * 272 + s20 * 2); \
            if (neg) { a.x ^= 0x80008000u; a.y ^= 0x80008000u; a.z ^= 0x80008000u; a.w ^= 0x80008000u; } \
            const bf16x8 Afr = __builtin_bit_cast(bf16x8, a); \
            _Pragma("unroll") for (int jp = 0; jp < 4; ++jp) acc[mt][jp] = __builtin_amdgcn_mfma_f32_16x16x32_bf16(Afr, Bf[jp], acc[mt][jp], 0, 0, 0); } } while (0)
    v2u Xa[8], Xb[8];
    DFT2_LOAD(Xa, 0);
#pragma unroll 1
    for (int ks = 0; ks < nks; ks += 2) {
        DFT2_LOAD(Xb, ks + 1);
        DFT2_STEP(Xa, ks);
        if (ks + 2 < nks) DFT2_LOAD(Xa, ks + 2);
        DFT2_STEP(Xb, ks + 1);
    }
#undef DFT2_LOAD
#undef DFT2_STEP
    LAS unsigned char* xc = F.lds + L_XC + F.wave * 8704;
    const bf16* WCT = (const bf16*)(F.ws + WS_WCT) + (size_t)(l * 8 + h) * 64 * 128;
    bf16* A2 = (bf16*)(F.ws + WS_A2) + (size_t)(tokS + k1) * A2P + h * 64 + 4 * q;
#pragma unroll
    for (int p = 0; p < 2; ++p) {
#pragma unroll
        for (int mm = 0; mm < 2; ++mm)
#pragma unroll
            for (int ty = 0; ty < 2; ++ty) {
                pg8::f32x4 v0, v1, v2, v3;
                if (p == 0) { v0 = acc[ty * 4 + mm][0]; v1 = acc[ty * 4 + mm][1]; v2 = acc[ty * 4 + mm][2]; v3 = acc[ty * 4 + mm][3]; }
                else { v0 = acc[ty * 4 + 2 + mm][0]; v1 = acc[ty * 4 + 2 + mm][1]; v2 = acc[ty * 4 + 2 + mm][2]; v3 = acc[ty * 4 + 2 + mm][3]; }
#pragma unroll
                for (int r = 0; r < 4; ++r) { v2u o; o.x = pk2(v0[r], v1[r]); o.y = pk2(v2[r], v3[r]);
                    *(LAS v2u*)(xc + (16 * mm + 4 * g + r) * 272 + (ty * 64 + 4 * q) * 2) = o; }
            }
        LDS_WAIT(); asm volatile("" ::: "memory");
        pg8::f32x4 yP[2][4], yQ[2][4];
#pragma unroll
        for (int mm = 0; mm < 2; ++mm)
#pragma unroll
            for (int jp = 0; jp < 4; ++jp) { yP[mm][jp] = (pg8::f32x4){0.f, 0.f, 0.f, 0.f}; yQ[mm][jp] = (pg8::f32x4){0.f, 0.f, 0.f, 0.f}; }
#pragma unroll
        for (int ksb = 0; ksb < 4; ++ksb) {
            bf16x8 Af2[2], Bf2[4];
#pragma unroll
            for (int mm = 0; mm < 2; ++mm) Af2[mm] = *(const LAS bf16x8*)(xc + (16 * mm + q) * 272 + (32 * ksb + 8 * g) * 2);
#pragma unroll
            for (int jp = 0; jp < 4; ++jp) Bf2[jp] = __builtin_bit_cast(bf16x8, *(const GAS v4u*)(WCT + (size_t)(4 * q + jp) * 128 + 32 * ksb + 8 * g));
#pragma unroll
            for (int mm = 0; mm < 2; ++mm)
#pragma unroll
                for (int jp = 0; jp < 4; ++jp) { if (ksb < 2) yP[mm][jp] = __builtin_amdgcn_mfma_f32_16x16x32_bf16(Af2[mm], Bf2[jp], yP[mm][jp], 0, 0, 0);
                                                 else yQ[mm][jp] = __builtin_amdgcn_mfma_f32_16x16x32_bf16(Af2[mm], Bf2[jp], yQ[mm][jp], 0, 0, 0); }
        }
        LDS_WAIT(); asm volatile("" ::: "memory");
        const bool mir = (k1 >= 1) && (k1 <= 31);
#pragma unroll
        for (int mm = 0; mm < 2; ++mm)
#pragma unroll
            for (int r = 0; r < 4; ++r) { const int k2 = 64 * kh + 32 * p + 16 * mm + 4 * g + r;
                v2u o; o.x = pk2(yP[mm][0][r] + yQ[mm][0][r], yP[mm][1][r] + yQ[mm][1][r]); o.y = pk2(yP[mm][2][r] + yQ[mm][2][r], yP[mm][3][r] + yQ[mm][3][r]);
                *(GAS v2u*)(A2 + (size_t)(64 * k2) * A2P) = o;
                if (mir) { v2u om; om.x = pk2(yP[mm][0][r] - yQ[mm][0][r], yP[mm][1][r] - yQ[mm][1][r]); om.y = pk2(yP[mm][2][r] - yQ[mm][2][r], yP[mm][3][r] - yQ[mm][3][r]);
                    *(GAS v2u*)(A2 + ((ptrdiff_t)64 * (N2 - 1 - k2) + 64 - 2 * k1) * A2P) = om; } }
    }
}
__device__ __forceinline__ void dft2_sample_unit(Frame& F, int l, int u2) { const int h = u2 & 7, t = u2 >> 3, k1 = t % 33, b = 2 + t / 33; dft2_unit(F, l, b, k1, h, 0); }
__device__ __forceinline__ void dft2_phase(Frame& F, int l) {
    const int gw = F.vcu * NWAVES + F.wave, NGW = F.G * NWAVES;
    if (NGW == 2048) {
        if (gw < 1056) { const int h = gw & 7, kh = (gw >> 3) & 1, t = gw >> 4, k1 = t % 33, b = t / 33; dft2_unit(F, l, b, k1, h, kh); }
        else { dft2_sample_unit(F, l, gw - 1056); if (gw - 1056 < 64) dft2_sample_unit(F, l, 992 + gw - 1056); }
    } else {
#pragma unroll 1
        for (int id = gw; id < 2112; id += NGW) {
            if (id < 1056) { const int h = id & 7, kh = (id >> 3) & 1, t = id >> 4, k1 = t % 33, b = t / 33; dft2_unit(F, l, b, k1, h, kh); }
            else dft2_sample_unit(F, l, id - 1056); }
    }
}
struct Args { const float* in[21]; float* out; unsigned char* ws; int ph_lo, ph_hi; };
__global__ void __launch_bounds__(NWAVES * 64, 2) mk_fwd(Args args) {
    extern __shared__ __attribute__((aligned(16))) unsigned char lds[];
    Frame F;
    F.lds = (LAS unsigned char*)lds;
    F.MISC = (volatile LAS unsigned*)(F.lds + MISC_OFF);
    F.tid = threadIdx.x; F.lane = F.tid & 63; F.wave = __builtin_amdgcn_readfirstlane(F.tid >> 6);
    F.G = gridDim.x; { const int bx = blockIdx.x; F.vcu = (F.G % 8 == 0) ? (bx % 8) * (F.G / 8) + bx / 8 : bx; }
#pragma unroll
    for (int i = 0; i < 21; ++i) F.in[i] = args.in[i];
    F.out = args.out; F.ws = args.ws; F.ctl = (gu32*)(args.ws + WS_CTL);
    if (F.tid < 64) ((LAS unsigned*)(F.lds + MISC_OFF))[F.tid] = 0u;
#ifdef DBG_ZERO_LDS
    for (int i = F.tid + (DBG_ZERO_LO) / 16; i < (DBG_ZERO_HI) / 16; i += NWAVES * 64) *(LAS v4u*)(F.lds + i * 16) = (v4u){0u, 0u, 0u, 0u};
#endif
    __syncthreads();
    XcdBarrier bar; bar.bar = (unsigned*)(F.ctl + CW_BAR); bar.x = 0; bar.st = nullptr;
    if (N_LAUNCHES == 1) bar = xcd_barrier_post((unsigned*)(F.ctl + CW_BAR), F.MISC + 8);
    const int lo = args.ph_lo, hi = args.ph_hi;
#define IN(k) (lo <= (k) && (k) < hi)
#ifndef WGPRE
#define WGPRE 1
#endif
#ifndef G4_REV
#define G4_REV 1
#endif
#ifndef LRU_STORE
#define LRU_STORE 1
#endif
#ifndef REP_P0
#define REP_P0 1
#endif
#ifndef REP_G1
#define REP_G1 1
#endif
#ifndef REP_M
#define REP_M 1
#endif
#ifndef REP_G3
#define REP_G3 1
#endif
#ifndef REP_LRU
#define REP_LRU 1
#endif
#ifndef REP_DFT
#define REP_DFT 1
#endif
#ifdef TEL_A0
#define STAMP(i) do { if (blockIdx.x == 0 && F.tid == 0) ((unsigned long long*)(F.ws + WS_CTL + 65536))[i] = __builtin_amdgcn_s_memrealtime(); } while (0)
#else
#define STAMP(i) do { } while (0)
#endif
#ifdef TEL_A0
#define TELP(k) ((unsigned long long*)(F.ws + WS_CTL + 65536) + 40 + (k))
#else
#define TELP(k) ((unsigned long long*)nullptr)
#endif
#define SEAM(k) do { STAMP(2 * (k) + 1); if (IN(k) && IN((k) + 1)) xcd_barrier(bar); STAMP(2 * (k) + 2); } while (0)
#ifndef BPRE
#define BPRE 1
#endif
#define SEAM_PF(k, GEMM_, SINIT_) do { STAMP(2 * (k) + 1); if (IN(k) && IN((k) + 1)) { if (BPRE) { const pg8::Gemm g_ = GEMM_; pg8::StaticOrder S_; S_.init SINIT_; \
        xcd_barrier_h(bar, [&]() { pg8::gemm_prefetch_b<true>(F.lds + RING_OFF, g_, S_, F.tid); }); } else xcd_barrier(bar); } STAMP(2 * (k) + 2); } while (0)
#define GEMM_G1(l_) pg8::Gemm{(const pg8::bf16_t*)(F.ws + WS_A), (const pg8::bf16_t*)(F.ws + WS_WIN) + (size_t)(l_) * 1536 * 1024, MTOK, DIN, D, (size_t)0}
#define GEMM_G2(l_) pg8::Gemm{(const pg8::bf16_t*)(F.ws + WS_A2), (const pg8::bf16_t*)(F.ws + WS_WEFF) + (size_t)(l_) * 1024 * 1024, MTOK, D, D, (size_t)0}
#define GEMM_G3(l_) pg8::Gemm{(const pg8::bf16_t*)(F.ws + WS_A), (const pg8::bf16_t*)(F.ws + WS_WFF1) + (size_t)(l_) * 4096 * 1024, MTOK, DFF, D, (size_t)0}
#define GEMM_G4(l_) pg8::Gemm{(const pg8::bf16_t*)(F.ws + WS_HMID), (const pg8::bf16_t*)(F.ws + WS_WFF2) + (size_t)(l_) * 1024 * 4096, MTOK, D, DFF, (size_t)0}
    STAMP(0);

    #ifndef NO_P0A
    if (IN(0)) { for (int rep_ = 0; rep_ < REP_P0; ++rep_) p0a(F); }
#endif
    SEAM(0);
    #ifndef NO_P0B
    if (IN(1)) { for (int rep_ = 0; rep_ < REP_P0; ++rep_) p0b(F); }
#endif
    SEAM(1);
    float* SS = (float*)(F.ws + WS_SS);
    const float* VEC = (const float*)(F.ws + WS_VEC);
#pragma unroll 1
    for (int l = 0; l < DEPTH; ++l) {
        const int pb = 2 + 6 * l;
#define REFRESH() do { int t_ = F.tid; asm volatile("" : "+v"(t_)); F.tid = t_; F.lane = t_ & 63; F.wave = __builtin_amdgcn_readfirstlane(t_ >> 6); } while (0)
#ifndef NO_G1
        if (IN(pb + 0)) for (int rep_ = 0; rep_ < REP_G1; ++rep_) { REFRESH();
            pg8::Gemm g{(const pg8::bf16_t*)(F.ws + WS_A), l == 0 ? (const pg8::bf16_t*)(F.ws + WS_WIN0) : (const pg8::bf16_t*)(F.ws + WS_WIN) + (size_t)l * 1536 * 1024, MTOK, DIN, D, l == 0 ? (size_t)1536 * 1024 * 2 : (size_t)0};
            pg8::StaticOrder S; S.init(MTOK, DIN, F.G, (int)blockIdx.x);
            pg8::EpiScaleBias<0> E{(pg8::bf16_t*)(F.ws + WS_Z), DIN, SS, (const float*)(F.ws + WS_BIAS1) + (size_t)l * 6 * 1536, TELP(pb + 0)};
            pg8::gemm_phase<pg8::EpiScaleBias<0>, pg8::StaticOrder, true, true>(F.lds + RING_OFF, g, S, E, F.tid, BPRE && l > 0 && IN(pb - 1));
        }
#endif
#if WGPRE
        { STAMP(2 * (pb + 0) + 1); if (IN(pb + 0) && IN(pb + 1)) xcd_barrier_h(bar, [&]() { if (F.wave != 0 && F.vcu < 256) load_wg_tables(F, l, F.vcu >> 5, F.tid - 64, (NWAVES - 1) * 64); }); STAMP(2 * (pb + 0) + 2); }
#else
        SEAM(pb + 0);
#endif
#ifndef NO_M1
        if (IN(pb + 1)) for (int rep_ = 0; rep_ < REP_M; ++rep_) { REFRESH();
            for (int r2_ = 0; r2_ < REP_LRU; ++r2_) lru_phase<LRU_STORE ? 2 : 0>(F, l, WGPRE && r2_ == 0 && rep_ == 0 && IN(pb + 0));
            if (l == 0) STAMP(31);
            __syncthreads();
            load_t1(F);
            __syncthreads();
            for (int r2_ = 0; r2_ < REP_DFT; ++r2_) dft1_phase(F);
            if (l == 0) STAMP(32);
        }
#endif
        SEAM(pb + 1);
#ifndef NO_M2
        if (IN(pb + 2)) for (int rep_ = 0; rep_ < REP_M; ++rep_) { REFRESH();
            for (int r2_ = 0; r2_ < REP_LRU; ++r2_) { if (LRU_STORE) lru_light_phase(F, l); else lru_phase<1>(F, l); }
            if (l == 0) STAMP(33);
            __syncthreads();
            if (l == 0) STAMP(36);
            load_t2(F);
            __syncthreads();
            if (l == 0) STAMP(34);
            for (int r2_ = 0; r2_ < REP_DFT; ++r2_) dft2_phase(F, l);
            if (l == 0) STAMP(35);
        }
#endif
        SEAM_PF(pb + 2, GEMM_G2(l), (MTOK, D, F.G, (int)blockIdx.x));
#ifndef NO_G2
        if (IN(pb + 3)) { REFRESH();
            pg8::Gemm g{(const pg8::bf16_t*)(F.ws + WS_A2), (const pg8::bf16_t*)(F.ws + WS_WEFF) + (size_t)l * 1024 * 1024, MTOK, D, D, 0};
            pg8::StaticOrder S; S.init(MTOK, D, F.G, (int)blockIdx.x);
            pg8::bf16_t* XB = (pg8::bf16_t*)F.out;
            if (l == 0) { pg8::EpiResidual<true> E{F.in[I_XP], F.in[I_XS], XB, (pg8::bf16_t*)(F.ws + WS_A), SS, VEC + (size_t)l * 6 * 4096 + 1 * 1024, VEC + (size_t)l * 6 * 4096 + 2 * 1024, TELP(pb + 3), 0};
                pg8::gemm_phase<pg8::EpiResidual<true>, pg8::StaticOrder, true, true>(F.lds + RING_OFF, g, S, E, F.tid, BPRE && IN(pb + 2)); }
            else { pg8::EpiResidual<false> E{XB, XB, XB, (pg8::bf16_t*)(F.ws + WS_A), SS, VEC + (size_t)l * 6 * 4096 + 1 * 1024, VEC + (size_t)l * 6 * 4096 + 2 * 1024, TELP(pb + 3), 0};
                pg8::gemm_phase<pg8::EpiResidual<false>, pg8::StaticOrder, true, true>(F.lds + RING_OFF, g, S, E, F.tid, BPRE && IN(pb + 2)); }
        }
#endif
        SEAM_PF(pb + 3, GEMM_G3(l), (MTOK, DFF, F.G, (int)blockIdx.x));
#ifndef NO_G3
        if (IN(pb + 4)) for (int rep_ = 0; rep_ < REP_G3; ++rep_) { REFRESH();
            pg8::Gemm g{(const pg8::bf16_t*)(F.ws + WS_A), (const pg8::bf16_t*)(F.ws + WS_WFF1) + (size_t)l * 4096 * 1024, MTOK, DFF, D, 0};
            pg8::StaticOrder S; S.init(MTOK, DFF, F.G, (int)blockIdx.x);
            pg8::EpiScaleBias<1> E{(pg8::bf16_t*)(F.ws + WS_HMID), DFF, SS, (const float*)(F.ws + WS_BIAS2) + (size_t)l * 6 * 4096, TELP(pb + 4)};
            pg8::gemm_phase<pg8::EpiScaleBias<1>, pg8::StaticOrder, true, true>(F.lds + RING_OFF, g, S, E, F.tid, BPRE && IN(pb + 3));
        }
#endif
        SEAM_PF(pb + 4, GEMM_G4(l), (MTOK, D, F.G, (int)blockIdx.x, G4_REV));
#ifndef NO_G4
        if (IN(pb + 5)) { REFRESH();
            pg8::Gemm g{(const pg8::bf16_t*)(F.ws + WS_HMID), (const pg8::bf16_t*)(F.ws + WS_WFF2) + (size_t)l * 1024 * 4096, MTOK, D, DFF, 0};
            pg8::StaticOrder S; S.init(MTOK, D, F.G, (int)blockIdx.x, G4_REV);
            const int ln = l + 1 < DEPTH ? l + 1 : l;
            pg8::bf16_t* XB = (pg8::bf16_t*)F.out;
            if (l + 1 < DEPTH) { pg8::EpiResidual<false, false> E{XB, XB, XB, (pg8::bf16_t*)(F.ws + WS_A), SS, VEC + (size_t)l * 6 * 4096 + 3 * 1024, VEC + (size_t)ln * 6 * 4096 + 0 * 1024, TELP(pb + 5), 0};
                pg8::gemm_phase<pg8::EpiResidual<false, false>, pg8::StaticOrder, true, true>(F.lds + RING_OFF, g, S, E, F.tid, BPRE && IN(pb + 4)); }
            else { pg8::EpiResidual<false, true> E{XB, XB, XB, (pg8::bf16_t*)(F.ws + WS_A), SS, VEC + (size_t)l * 6 * 4096 + 3 * 1024, VEC + (size_t)ln * 6 * 4096 + 0 * 1024, TELP(pb + 5), 1};
                pg8::gemm_phase<pg8::EpiResidual<false, true>, pg8::StaticOrder, true, true>(F.lds + RING_OFF, g, S, E, F.tid, BPRE && IN(pb + 4)); }
        }
#endif
        if (l + 1 < DEPTH) SEAM_PF(pb + 5, GEMM_G1(l + 1), (MTOK, DIN, F.G, (int)blockIdx.x)); else SEAM(pb + 5);
    }
    if (IN(14)) { REFRESH(); final_norm(F); }
    STAMP(29);
#ifdef TEL_A0
    if (blockIdx.x == 0 && F.tid == 0) {
        const unsigned long long* T = (const unsigned long long*)(F.ws + WS_CTL + 65536);
        const unsigned long long t0 = __builtin_amdgcn_s_memrealtime(), target = (unsigned long long)TEL_K * (T[TEL_A1] - T[TEL_A0]);
        while (__builtin_amdgcn_s_memrealtime() - t0 < target) __builtin_amdgcn_s_sleep(16);
    }
#endif
#undef IN
#undef SEAM
}

extern "C" void kernel_launch(void* const* d_in, const int* in_sizes, int n_in, void* d_out, int out_size, void* d_ws, size_t ws_size, hipStream_t stream) {
    static int grid = 0;
    if (grid == 0) {
        if (n_in != 21 || out_size != MTOK * D || ws_size < WS_END) { fprintf(stderr, "kernel_launch: built for 21 inputs, %d outputs, >= %zu bytes of workspace; got %d, %d, %zu; nothing launched\n", MTOK * D, (size_t)WS_END, n_in, out_size, ws_size); grid = -1; return; }
        int dev = 0, cus = 0, per_cu = 0;
        if (hipGetDevice(&dev) != hipSuccess || hipDeviceGetAttribute(&cus, hipDeviceAttributeMultiprocessorCount, dev) != hipSuccess) { fprintf(stderr, "kernel_launch: device query failed\n"); grid = -1; return; }
        if (hipFuncSetAttribute((const void*)mk_fwd, hipFuncAttributeMaxDynamicSharedMemorySize, LDS_BYTES) != hipSuccess) { fprintf(stderr, "kernel_launch: hipFuncSetAttribute failed\n"); grid = -1; return; }
        if (hipOccupancyMaxActiveBlocksPerMultiprocessor(&per_cu, (const void*)mk_fwd, NWAVES * 64, LDS_BYTES) != hipSuccess || per_cu < 1) { fprintf(stderr, "kernel_launch: occupancy query reports %d workgroups per CU; nothing launched\n", per_cu); (void)hipGetLastError(); grid = -1; return; }
        (void)hipGetLastError();
        grid = cus;
    }
    if (grid < 0) return;
    (void)hipMemsetAsync((char*)d_ws + WS_CTL, 0, CTL_ZERO_BYTES, stream);
    Args a{};
    for (int i = 0; i < 21; ++i) a.in[i] = (const float*)d_in[i];
    a.out = (float*)d_out; a.ws = (unsigned char*)d_ws;
    if (N_LAUNCHES == 1) { a.ph_lo = 0; a.ph_hi = NPH; hipLaunchKernelGGL(mk_fwd, dim3(grid), dim3(NWAVES * 64), LDS_BYTES, stream, a); }
    else for (int p = 0; p < NPH; ++p) { a.ph_lo = p; a.ph_hi = p + 1; hipLaunchKernelGGL(mk_fwd, dim3(grid), dim3(NWAVES * 64), LDS_BYTES, stream, a); }
}
```
